# Optimizing an MI355X kernel written in HIP

```python
import math
import jax, jax.numpy as jnp
from jax import lax
import numpy as np

D_MODEL = 1024
BATCH = 4
SEQ = 8192
DEPTH = 1
DEC_BATCH = 8
DEC_SEQ = 4096
PAST_LEN = 128

HEAD_DIM = 64
N_ATTN_HEADS = 12
D_ATTN = N_ATTN_HEADS * HEAD_DIM
N_FOURIER_GROUPS = 4
FOURIER_GROUP = 64
D_FOURIER = N_FOURIER_GROUPS * FOURIER_GROUP
D_MIX = D_ATTN + D_FOURIER
D_IN_PROJ = 4 * D_ATTN + 2 * D_FOURIER
PATTERNS = ((128, 1), (512, 4), (2048, 16))
BLOCK = 64
N_BUCKETS = 32
MAX_DISTANCE = 1024
RMS_EPS = 1e-6
NEG = -1e30

kernel_name = "hybrid_dilated_attn_fnet_encoder"


def rmsnorm(x, g):
    xf = x.astype(jnp.float32)
    y = xf * lax.rsqrt(jnp.mean(xf * xf, axis=-1, keepdims=True) + RMS_EPS) * g.astype(jnp.float32)
    return y.astype(x.dtype)


def t5_bucket(rel):
    half = N_BUCKETS // 2
    max_exact = half // 2
    ret = jnp.where(rel > 0, half, 0)
    n = jnp.abs(rel)
    nf = jnp.maximum(n, 1).astype(jnp.float32)
    large = max_exact + (jnp.log(nf / max_exact) / math.log(MAX_DISTANCE / max_exact)
                         * (half - max_exact)).astype(jnp.int32)
    large = jnp.minimum(large, half - 1)
    return ret + jnp.where(n < max_exact, n, large)


def dilated_window_attention(q, k, v, rel_bias, window, dil):
    B, S, H, Dh = q.shape
    half = window // (2 * dil)
    L = S // dil
    nb = -(-L // BLOCK)
    Lp = nb * BLOCK

    def to_residue(t):
        return t.reshape(B, L, dil, H, Dh).transpose(0, 2, 1, 3, 4)

    qr, kr, vr = to_residue(q), to_residue(k), to_residue(v)
    qb = jnp.pad(qr, ((0, 0), (0, 0), (0, Lp - L), (0, 0), (0, 0))).reshape(B, dil, nb, BLOCK, H, Dh)

    def key_blocks(t):
        tp = jnp.pad(t, ((0, 0), (0, 0), (BLOCK, Lp - L + BLOCK), (0, 0), (0, 0)))
        tp = tp.reshape(B, dil, nb + 2, BLOCK, H, Dh)
        return jnp.concatenate([tp[:, :, 0:nb], tp[:, :, 1:nb + 1], tp[:, :, 2:nb + 2]], axis=3)

    kb, vb = key_blocks(kr), key_blocks(vr)

    a = jnp.arange(BLOCK, dtype=jnp.int32)[:, None]
    c = jnp.arange(3 * BLOCK, dtype=jnp.int32)[None, :]
    rel = c - BLOCK - a
    band = jnp.abs(rel) <= half
    key_pos = jnp.arange(nb, dtype=jnp.int32)[:, None] * BLOCK + jnp.arange(3 * BLOCK, dtype=jnp.int32)[None, :] - BLOCK
    in_range = (key_pos >= 0) & (key_pos < L)
    mask = band[None] & in_range[:, None, :]
    bias = rel_bias[t5_bucket(rel * dil)].astype(jnp.float32).transpose(2, 0, 1)

    scale = 1.0 / math.sqrt(Dh)
    s = jnp.einsum('brnqhd,brnkhd->brnhqk', qb, kb, preferred_element_type=jnp.float32) * scale + bias
    s = jnp.where(mask[:, None], s, NEG)
    lse = jax.nn.logsumexp(s, axis=-1)
    p = jnp.exp(s - lse[..., None])
    o = jnp.einsum('brnhqk,brnkhd->brnqhd', p.astype(vb.dtype), vb, preferred_element_type=jnp.float32)
    o = o.reshape(B, dil, Lp, H, Dh)[:, :, :L].transpose(0, 2, 1, 3, 4).reshape(B, S, H, Dh)
    lse = lse.transpose(0, 1, 2, 4, 3).reshape(B, dil, Lp, H)[:, :, :L].transpose(0, 2, 1, 3).reshape(B, S, H)
    return o, lse


def encoder_layer(x, norm_g, w_in, q_g, k_g, rel_bias, w_four, w_out):
    B, S, _ = x.shape
    h = rmsnorm(x, norm_g)
    proj = h @ w_in
    q, k, v, g_attn, u, g_four = jnp.split(
        proj, [D_ATTN, 2 * D_ATTN, 3 * D_ATTN, 4 * D_ATTN, 4 * D_ATTN + D_FOURIER], axis=-1)

    q = rmsnorm(q.reshape(B, S, N_ATTN_HEADS, HEAD_DIM), q_g)
    k = rmsnorm(k.reshape(B, S, N_ATTN_HEADS, HEAD_DIM), k_g)
    v = v.reshape(B, S, N_ATTN_HEADS, HEAD_DIM)
    outs, lses = [], []
    for window, dil in PATTERNS:
        o, l = dilated_window_attention(q, k, v, rel_bias, window, dil)
        outs.append(o)
        lses.append(l)
    wts = jax.nn.softmax(jnp.stack(lses), axis=0)
    attn = jnp.einsum('pbsh,pbshd->bshd', wts, jnp.stack(outs))
    attn = attn.reshape(B, S, D_ATTN).astype(x.dtype) * jax.nn.silu(g_attn)

    uf = u.astype(jnp.float32).reshape(B, S, N_FOURIER_GROUPS, FOURIER_GROUP)
    mixed = jnp.fft.fftn(uf, axes=(1, 3), norm="ortho").real
    four = jnp.einsum('bsgc,gce->bsge', mixed.astype(x.dtype), w_four).reshape(B, S, D_FOURIER)
    four = four * jax.nn.silu(g_four)

    y = jnp.concatenate([attn, four], axis=-1) @ w_out
    return x + y


def setup_inputs(seed: int = 0) -> dict:
    key = jax.random.key(seed)
    ks = jax.random.split(key, 10)
    f32 = jnp.float32
    x_prompt = jax.random.normal(ks[0], (BATCH, SEQ, D_MODEL), f32)
    x_sample = jax.random.normal(ks[1], (DEC_BATCH, DEC_SEQ, D_MODEL), f32)
    norm_g = 1.0 + 0.01 * jax.random.normal(ks[2], (DEPTH, D_MODEL), f32)
    w_in = jax.random.normal(ks[3], (DEPTH, D_MODEL, D_IN_PROJ), f32) * D_MODEL ** -0.5
    q_norm_g = 1.0 + 0.01 * jax.random.normal(ks[4], (DEPTH, HEAD_DIM), f32)
    k_norm_g = 1.0 + 0.01 * jax.random.normal(ks[5], (DEPTH, HEAD_DIM), f32)
    rel_bias = 0.1 * jax.random.normal(ks[6], (N_BUCKETS, N_ATTN_HEADS), f32)
    w_four = jax.random.normal(ks[7], (DEPTH, N_FOURIER_GROUPS, FOURIER_GROUP, FOURIER_GROUP), f32) * FOURIER_GROUP ** -0.5
    w_out = jax.random.normal(ks[8], (DEPTH, D_MIX, D_MODEL), f32) * D_MIX ** -0.5
    return {"x_prompt": x_prompt, "x_sample": x_sample, "norm_g": norm_g, "w_in": w_in,
            "q_norm_g": q_norm_g, "k_norm_g": k_norm_g, "rel_bias": rel_bias,
            "w_four": w_four, "w_out": w_out}


def reference(x_prompt, x_sample, norm_g, w_in, q_norm_g, k_norm_g, rel_bias, w_four, w_out):
    y_prompt = x_prompt
    y_sample = x_sample
    for layer in range(DEPTH):
        y_prompt = encoder_layer(y_prompt, norm_g[layer], w_in[layer], q_norm_g[layer], k_norm_g[layer],
                                 rel_bias, w_four[layer], w_out[layer])
        y_sample = encoder_layer(y_sample, norm_g[layer], w_in[layer], q_norm_g[layer], k_norm_g[layer],
                                 rel_bias, w_four[layer], w_out[layer])
    return (y_prompt, y_sample)
```

```cpp
#include <hip/hip_runtime.h>
#include <hip/hip_cooperative_groups.h>
#include <cstdio>
#include <cstdint>
namespace cg = cooperative_groups;

#define DI __device__ __forceinline__
#define LAS __attribute__((address_space(3)))
typedef unsigned short bf16_t;
typedef short bf16x8 __attribute__((ext_vector_type(8)));
typedef short s16x4 __attribute__((ext_vector_type(4)));
typedef float f32x4 __attribute__((ext_vector_type(4)));
typedef float f32x16 __attribute__((ext_vector_type(16)));
typedef unsigned u32x4 __attribute__((ext_vector_type(4)));
typedef unsigned u32x2 __attribute__((ext_vector_type(2)));
typedef float f32x2_t __attribute__((ext_vector_type(2)));
typedef __bf16 bf16x2_t __attribute__((ext_vector_type(2)));
typedef short v4i16_t __attribute__((ext_vector_type(4)));

DI unsigned pk2(float lo, float hi) { f32x2_t v = {lo, hi}; bf16x2_t b = __builtin_convertvector(v, bf16x2_t); return __builtin_bit_cast(unsigned, b); }
DI float bflo(unsigned u) { return __uint_as_float(u << 16); }
DI float bfhi(unsigned u) { return __uint_as_float(u & 0xffff0000u); }
DI float silu_f(float v) { return v * __frcp_rn(1.0f + __expf(-v)); }
DI float wave_sum(float v) {
#pragma unroll
    for (int o = 1; o < 64; o <<= 1) v += __shfl_xor(v, o);
    return v;
}
#define LDS_WAIT() asm volatile("s_waitcnt lgkmcnt(0)" ::: "memory")
DI int fresh_tid() { int t = threadIdx.x; asm volatile("" : "+v"(t)); return t; }

constexpr int NTOK = 65536, NPT = 32768, DM = 1024, DATT = 768, NPROJ = 3840, WIN_LD = 3584;
constexpr float RMS_EPS = 1e-6f;
constexpr float LOG2E = 1.4426950408889634f;
constexpr float C2 = 0.125f * LOG2E;

constexpr size_t MiB = 1u << 20;
constexpr size_t WS_CTL = 0;
constexpr size_t WS_WIN = 2 * MiB;
constexpr size_t WS_WOUT = 10 * MiB;
constexpr size_t WS_F1P = 12 * MiB;
constexpr size_t WS_F1S = WS_F1P + 131072;
constexpr size_t WS_F2 = WS_F1S + 32768;
constexpr size_t WS_TWP = WS_F2 + 16384;
constexpr size_t WS_TWS = WS_TWP + 65536;
constexpr size_t WS_TB = WS_TWS + 32768;
constexpr size_t WS_H = 16 * MiB;
constexpr size_t WS_V = 144 * MiB;
constexpr size_t WS_GA = 240 * MiB;
constexpr size_t WS_GF = 336 * MiB;
constexpr size_t WS_PO = 368 * MiB;
constexpr size_t WS_L = 464 * MiB;
constexpr size_t WS_END = 468 * MiB;
constexpr size_t DO_Q = 0, DO_K = 96 * MiB, DO_Z = 192 * MiB;

namespace pg8 {
#define PG8_LAS __attribute__((address_space(3)))
constexpr int BM = 256, BK = 64, HALF = 128, HTB = HALF * BK * 2, STAGE_BYTES = 8 * HTB, NXCD = 8, WGM = 8;
__host__ __device__ __forceinline__ int lds_byte(int r, int c) { const int st = (r >> 4) * 2 + (c >> 5), rr = r & 15, cc = c & 31, ob = rr * 64 + cc * 2; return st * 1024 + (ob ^ (((ob >> 9) & 1) << 5)); }
__host__ __device__ __forceinline__ void stage_rc(int b, int& R, int& C) { const int st = b / 1024, sb = b % 1024, swz = sb ^ (((sb >> 9) & 1) << 5); R = (st >> 1) * 16 + swz / 64; C = (st & 1) * 32 + (swz % 64) / 2; }
__host__ __device__ __forceinline__ int perm32(int rho) { const int n = rho >> 4, i = rho & 15; return 8 * (i >> 2) + 4 * n + (i & 3); }
struct Unit { int pm, pn; };
struct Gemm { const bf16_t* A; const bf16_t* Bt; int M, N, K; };
struct StaticOrder {
    int nM, nN, nwg, G, c, flip;
    __host__ __device__ void init(int M, int N, int G_, int c_, int flip_ = 0) { nM = M / BM; nN = N / BM; nwg = nM * nN; G = G_; c = c_; flip = flip_; }
    __host__ __device__ bool next(int i, Unit& u) const {
        const long L = (long)i * G + c; if (L >= nwg) return false;
        int wgid = (int)L; { const int q = nwg / NXCD, r = nwg % NXCD, xcd = wgid % NXCD, off = wgid / NXCD; wgid = (xcd < r ? xcd * (q + 1) : r * (q + 1) + (xcd - r) * q) + off; }
        const int nig = WGM * nN, gid = wgid / nig, fm = gid * WGM, gsz = (nM - fm) < WGM ? (nM - fm) : WGM;
        u.pm = fm + ((wgid % nig) % gsz); u.pn = (wgid % nig) / gsz; if (flip) u.pm = nM - 1 - u.pm; return true;
    }
    __device__ __forceinline__ void a_ready(const Unit&) const {}
    __device__ __forceinline__ void done(const Unit&) const {}
};
template <class Epi, class Sched, bool ALIGN_EPI = false, bool SP2 = false>
__device__ __forceinline__ void gemm_phase(PG8_LAS unsigned char* lds, const Gemm g, const Sched& S, const Epi& E) {
    const int tid = fresh_tid(), wid = __builtin_amdgcn_readfirstlane(tid >> 6), lane = tid & 63, wr = wid >> 2, wc = wid & 3, fr = lane & 15, fq = lane >> 4;
    const int K = g.K, nt = K / BK;
    unsigned voffA[2], voffB[2];
#pragma unroll
    for (int i = 0; i < 2; ++i) { int R, C; stage_rc(tid * 16 + i * 8192, R, C); const int Rb = Epi::PERM ? ((R & ~31) + perm32(R & 31)) : R;
        voffA[i] = (unsigned)(R * K + C) * 2u; voffB[i] = (unsigned)(Rb * K + C) * 2u; }
    const size_t kstep = (size_t)(BK * 2);
    const size_t hstep = (size_t)HALF * K * 2;
    const size_t tstep = 2 * hstep;
    const unsigned ldsw = (unsigned)wid * 1024u;
    const int aoff = lds_byte(wr * 64 + fr, fq * 8), boff = lds_byte(wc * 32 + fr, fq * 8);
#define PG8_SA(b, h) (((b) * 2 + (h)) * HTB)
#define PG8_SB(b, h) ((4 + (b) * 2 + (h)) * HTB)
#define PG8_STAGE(bufoff, gbase, voff) do { _Pragma("unroll") for (int _i = 0; _i < 2; ++_i) \
        __builtin_amdgcn_global_load_lds((const unsigned*)((const char*)(gbase) + (voff)[_i]), (PG8_LAS unsigned*)(lds + (bufoff) + ldsw + _i * 8192), 16, 0, 0); } while (0)
#define PG8_LDA(dst, b, h) do { _Pragma("unroll") for (int m = 0; m < 4; ++m) _Pragma("unroll") for (int k = 0; k < 2; ++k) dst[m][k] = *(const PG8_LAS bf16x8*)(lds + PG8_SA(b, h) + aoff + m * 2048 + k * 1024); } while (0)
#define PG8_LDB(dst, b, h) do { _Pragma("unroll") for (int n = 0; n < 2; ++n) _Pragma("unroll") for (int k = 0; k < 2; ++k) dst[n][k] = *(const PG8_LAS bf16x8*)(lds + PG8_SB(b, h) + boff + n * 2048 + k * 1024); } while (0)
#define PG8_MMA(ai, bj, At, Bt) do { __builtin_amdgcn_s_setprio(1); _Pragma("unroll") for (int m = 0; m < 4; ++m) _Pragma("unroll") for (int n = 0; n < 2; ++n) _Pragma("unroll") for (int k = 0; k < 2; ++k) \
        acc[ai][bj][m][n] = __builtin_amdgcn_mfma_f32_16x16x32_bf16(Bt[n][k], At[m][k], acc[ai][bj][m][n], 0, 0, 0); __builtin_amdgcn_s_setprio(0); } while (0)
#define PG8_WAIT_V(n) asm volatile("s_waitcnt vmcnt(" #n ")" ::: "memory")
#define PG8_WAIT_L(n) asm volatile("s_waitcnt lgkmcnt(" #n ")" ::: "memory")
#define PG8_BAR __builtin_amdgcn_s_barrier()
#define PG8_SCHED __builtin_amdgcn_sched_barrier(0)
    Unit cur, nxt; int ui = 0;
    if (!S.next(0, cur)) return;
    f32x4 acc[2][2][4][2];
#pragma unroll
    for (int a = 0; a < 2; ++a)
#pragma unroll
        for (int b = 0; b < 2; ++b)
#pragma unroll
            for (int m = 0; m < 4; ++m)
#pragma unroll
                for (int n = 0; n < 2; ++n) acc[a][b][m][n] = (f32x4){0.f, 0.f, 0.f, 0.f};
    bf16x8 At[4][2], B0[2][2], B1[2][2];
    const char* cA = (const char*)g.A + (size_t)cur.pm * tstep; const char* cB = (const char*)g.Bt + (size_t)cur.pn * tstep;
    S.a_ready(cur);
    if constexpr (SP2) {
        PG8_STAGE(PG8_SB(0, 0), cB, voffB); PG8_STAGE(PG8_SB(0, 1), cB + hstep, voffB); PG8_STAGE(PG8_SA(0, 0), cA, voffA); PG8_STAGE(PG8_SA(0, 1), cA + hstep, voffA);
        if (wr == 1) PG8_BAR;
        PG8_WAIT_V(2); PG8_BAR;
        PG8_STAGE(PG8_SB(1, 0), cB + kstep, voffB); PG8_STAGE(PG8_SA(1, 0), cA + kstep, voffA); PG8_STAGE(PG8_SB(1, 1), cB + hstep + kstep, voffB);
        PG8_WAIT_V(6); PG8_BAR;
    } else {
        PG8_STAGE(PG8_SB(0, 0), cB, voffB); PG8_STAGE(PG8_SA(0, 0), cA, voffA); PG8_STAGE(PG8_SB(0, 1), cB + hstep, voffB); PG8_STAGE(PG8_SA(0, 1), cA + hstep, voffA);
        if (wr == 1) PG8_BAR;
        PG8_WAIT_V(4); PG8_BAR;
        PG8_STAGE(PG8_SB(1, 0), cB + kstep, voffB); PG8_STAGE(PG8_SA(1, 0), cA + kstep, voffA); PG8_STAGE(PG8_SB(1, 1), cB + hstep + kstep, voffB);
        PG8_WAIT_V(6); PG8_BAR;
    }
    for (;;) {
        const bool has_next = S.next(ui + 1, nxt);
        const char* nA = has_next ? (const char*)g.A + (size_t)nxt.pm * tstep : cA; const char* nB = has_next ? (const char*)g.Bt + (size_t)nxt.pn * tstep : cB;
        for (int t = 0; t < nt; t += 2) {
            const bool last = (t == nt - 2);
            const char* a1 = cA + (size_t)(t + 1) * kstep;
            const char* a2 = last ? nA : cA + (size_t)(t + 2) * kstep; const char* b2 = last ? nB : cB + (size_t)(t + 2) * kstep;
            const char* a3 = a2 + kstep; const char* b3 = b2 + kstep;
            if (last && has_next) S.a_ready(nxt);
            if constexpr (SP2) {
            PG8_LDB(B0, 0, 0); PG8_LDB(B1, 0, 1); PG8_SCHED; PG8_LDA(At, 0, 0); PG8_STAGE(PG8_SA(1, 1), a1 + hstep, voffA);
            PG8_WAIT_V(8); PG8_WAIT_L(0); PG8_BAR; PG8_MMA(0, 0, At, B0); PG8_MMA(0, 1, At, B1); PG8_BAR; PG8_SCHED;
            PG8_LDA(At, 0, 1); PG8_STAGE(PG8_SB(0, 0), b2, voffB); PG8_STAGE(PG8_SB(0, 1), b2 + hstep, voffB); PG8_STAGE(PG8_SA(0, 0), a2, voffA);
            PG8_WAIT_V(8); PG8_WAIT_L(0); PG8_BAR; PG8_MMA(1, 0, At, B0); PG8_MMA(1, 1, At, B1); PG8_BAR; PG8_SCHED;
            PG8_LDB(B0, 1, 0); PG8_LDB(B1, 1, 1); PG8_SCHED; PG8_LDA(At, 1, 0); PG8_STAGE(PG8_SA(0, 1), a2 + hstep, voffA);
            PG8_WAIT_V(8); PG8_WAIT_L(0); PG8_BAR; PG8_MMA(0, 0, At, B0); PG8_MMA(0, 1, At, B1); PG8_BAR; PG8_SCHED;
            PG8_LDA(At, 1, 1); PG8_STAGE(PG8_SB(1, 0), b3, voffB); PG8_STAGE(PG8_SB(1, 1), b3 + hstep, voffB); PG8_STAGE(PG8_SA(1, 0), a3, voffA);
            PG8_WAIT_V(8); PG8_WAIT_L(0); PG8_BAR; PG8_MMA(1, 0, At, B0); PG8_MMA(1, 1, At, B1); PG8_BAR; PG8_SCHED;
            } else {
            PG8_LDB(B0, 0, 0); PG8_SCHED; PG8_LDA(At, 0, 0); PG8_STAGE(PG8_SA(1, 1), a1 + hstep, voffA);
            PG8_WAIT_L(8); PG8_BAR; PG8_WAIT_L(0); PG8_MMA(0, 0, At, B0); PG8_BAR; PG8_SCHED;
            PG8_LDB(B1, 0, 1); PG8_STAGE(PG8_SB(0, 0), b2, voffB);
            PG8_BAR; PG8_WAIT_L(0); PG8_MMA(0, 1, At, B1); PG8_BAR;
            PG8_LDA(At, 0, 1); PG8_STAGE(PG8_SA(0, 0), a2, voffA);
            PG8_BAR; PG8_WAIT_L(0); PG8_MMA(1, 0, At, B0); PG8_BAR; PG8_SCHED;
            PG8_STAGE(PG8_SB(0, 1), b2 + hstep, voffB);
            PG8_WAIT_V(6); PG8_BAR; PG8_MMA(1, 1, At, B1); PG8_BAR;
            PG8_LDB(B0, 1, 0); PG8_SCHED; PG8_LDA(At, 1, 0); PG8_STAGE(PG8_SA(0, 1), a2 + hstep, voffA);
            PG8_WAIT_L(8); PG8_BAR; PG8_WAIT_L(0); PG8_MMA(0, 0, At, B0); PG8_BAR; PG8_SCHED;
            PG8_LDB(B1, 1, 1); PG8_STAGE(PG8_SB(1, 0), b3, voffB);
            PG8_BAR; PG8_WAIT_L(0); PG8_MMA(0, 1, At, B1); PG8_BAR;
            PG8_LDA(At, 1, 1); PG8_STAGE(PG8_SA(1, 0), a3, voffA);
            PG8_BAR; PG8_WAIT_L(0); PG8_MMA(1, 0, At, B0); PG8_BAR; PG8_SCHED;
            PG8_STAGE(PG8_SB(1, 1), b3 + hstep, voffB);
            PG8_WAIT_V(6); PG8_BAR; PG8_MMA(1, 1, At, B1); PG8_BAR;
            }
        }
        if constexpr (ALIGN_EPI) { if (wr == 0) PG8_BAR; }
        E(acc, cur, wr, wc, fr, fq); S.done(cur);
        if (!has_next) break;
#pragma unroll
        for (int a = 0; a < 2; ++a)
#pragma unroll
            for (int b = 0; b < 2; ++b)
#pragma unroll
                for (int m = 0; m < 4; ++m)
#pragma unroll
                    for (int n = 0; n < 2; ++n) acc[a][b][m][n] = (f32x4){0.f, 0.f, 0.f, 0.f};
        cur = nxt; cA = nA; cB = nB; ++ui;
        if constexpr (ALIGN_EPI) { if (wr == 1) PG8_BAR; }
    }
    PG8_WAIT_V(0);
    if constexpr (!ALIGN_EPI) { if (wr == 0) PG8_BAR; }
    PG8_BAR;
#undef PG8_SA
#undef PG8_SB
#undef PG8_STAGE
#undef PG8_LDA
#undef PG8_LDB
#undef PG8_MMA
#undef PG8_WAIT_V
#undef PG8_WAIT_L
#undef PG8_BAR
#undef PG8_SCHED
}
}

struct EpiInProj {
    static constexpr bool PERM = true;
    bf16_t *Q, *K, *V, *GA, *Z, *GF; const float *qg, *kg;
    DI void store8(bf16_t* p, const f32x4& a, const f32x4& b) const {
        u32x4 w; w.x = pk2(a[0], a[1]); w.y = pk2(a[2], a[3]); w.z = pk2(b[0], b[1]); w.w = pk2(b[2], b[3]); *(u32x4*)p = w; }
    DI size_t hm_off(int pm, int head, int srow) const {
        int tokb, S, s0;
        if (pm < 128) { tokb = (pm >> 5) * 8192; S = 8192; s0 = (pm & 31) * 256; } else { const int q = pm - 128; tokb = NPT + (q >> 4) * 4096; S = 4096; s0 = (q & 15) * 256; }
        return ((size_t)tokb * 12 + (size_t)head * S + s0 + srow) * 64;
    }
    DI void operator()(const f32x4 (&acc)[2][2][4][2], const pg8::Unit& u, int wr, int wc, int fr, int fq) const {
        const int pn = u.pn; const int row0 = u.pm * 256 + wr * 64 + fr; const int srow0 = wr * 64 + fr;
        if (pn < 6) {
            const bool isq = pn < 3; const float* g = isq ? qg : kg; const float sc = isq ? C2 : 1.0f;
            bf16_t* O = isq ? Q : K; const int head = (isq ? pn : pn - 3) * 4 + wc;
            bf16_t* ob = O + hm_off(u.pm, head, srow0) + 8 * fq;
            f32x4 gv[2][2];
#pragma unroll
            for (int bj = 0; bj < 2; ++bj)
#pragma unroll
                for (int n = 0; n < 2; ++n) { gv[bj][n] = *(const f32x4*)(g + 32 * bj + 8 * fq + 4 * n); gv[bj][n] = gv[bj][n] * sc; }
#pragma unroll
            for (int ai = 0; ai < 2; ++ai)
#pragma unroll
                for (int m = 0; m < 4; ++m) {
                    float ss = 0.f;
#pragma unroll
                    for (int bj = 0; bj < 2; ++bj)
#pragma unroll
                        for (int n = 0; n < 2; ++n) { const f32x4 v = acc[ai][bj][m][n]; ss += (v[0] * v[0] + v[1] * v[1]) + (v[2] * v[2] + v[3] * v[3]); }
                    ss += __shfl_xor(ss, 16); ss += __shfl_xor(ss, 32);
                    const float rs = 1.0f / sqrtf(ss * (1.0f / 64.0f) + RMS_EPS);
                    bf16_t* rowp = ob + (size_t)(ai * 128 + m * 16) * 64;
#pragma unroll
                    for (int bj = 0; bj < 2; ++bj) store8(rowp + 32 * bj, acc[ai][bj][m][0] * rs * gv[bj][0], acc[ai][bj][m][1] * rs * gv[bj][1]);
                }
        } else if (pn < 9) {
            const int head = (pn - 6) * 4 + wc; bf16_t* ob = V + hm_off(u.pm, head, srow0) + 8 * fq;
#pragma unroll
            for (int ai = 0; ai < 2; ++ai)
#pragma unroll
                for (int m = 0; m < 4; ++m) { bf16_t* rowp = ob + (size_t)(ai * 128 + m * 16) * 64;
#pragma unroll
                    for (int bj = 0; bj < 2; ++bj) store8(rowp + 32 * bj, acc[ai][bj][m][0], acc[ai][bj][m][1]); }
        } else if (pn < 12) {
            const int head = (pn - 9) * 4 + wc; bf16_t* ob = GA + hm_off(u.pm, head, srow0) + 8 * fq;
#pragma unroll
            for (int ai = 0; ai < 2; ++ai)
#pragma unroll
                for (int m = 0; m < 4; ++m) { bf16_t* rowp = ob + (size_t)(ai * 128 + m * 16) * 64;
#pragma unroll
                    for (int bj = 0; bj < 2; ++bj) { f32x4 a = acc[ai][bj][m][0], b = acc[ai][bj][m][1];
#pragma unroll
                        for (int i = 0; i < 4; ++i) { a[i] = silu_f(a[i]); b[i] = silu_f(b[i]); }
                        store8(rowp + 32 * bj, a, b); } }
        } else if (pn < 14) {
            const int col = (pn - 12) * 256 + wc * 64 + 8 * fq;
#pragma unroll
            for (int ai = 0; ai < 2; ++ai)
#pragma unroll
                for (int m = 0; m < 4; ++m) { bf16_t* rowp = Z + (size_t)(row0 + ai * 128 + m * 16) * 512 + col;
#pragma unroll
                    for (int bj = 0; bj < 2; ++bj) store8(rowp + 32 * bj, acc[ai][bj][m][0], acc[ai][bj][m][1]); }
        } else {
            const int col = wc * 64 + 8 * fq;
#pragma unroll
            for (int ai = 0; ai < 2; ++ai)
#pragma unroll
                for (int m = 0; m < 4; ++m) { bf16_t* rowp = GF + (size_t)(row0 + ai * 128 + m * 16) * 256 + col;
#pragma unroll
                    for (int bj = 0; bj < 2; ++bj) { f32x4 a = acc[ai][bj][m][0], b = acc[ai][bj][m][1];
#pragma unroll
                        for (int i = 0; i < 4; ++i) { a[i] = silu_f(a[i]); b[i] = silu_f(b[i]); }
                        store8(rowp + 32 * bj, a, b); } }
        }
    }
};
struct EpiOut {
    static constexpr bool PERM = true;
    const float *xp, *xs; float* out; LAS unsigned char* stgbase;
    DI void operator()(const f32x4 (&acc)[2][2][4][2], const pg8::Unit& u, int wr, int wc, int fr, int fq) const {
        LAS unsigned char* stg = stgbase + (wr * 4 + wc) * 4096;
        const int lane = fq * 16 + fr, rr = lane >> 3, cc = lane & 7;
        const int rowb = u.pm * 256 + wr * 64, colb = u.pn * 256 + wc * 32;
        const float* xb = (u.pm < 128) ? xp + (size_t)rowb * DM : xs + (size_t)(rowb - NPT) * DM;
        float* ob = out + (size_t)rowb * DM;
#pragma unroll
        for (int ai = 0; ai < 2; ++ai) {
            f32x4 xv[4][2][2];
#pragma unroll
            for (int m = 0; m < 4; ++m)
#pragma unroll
                for (int bj = 0; bj < 2; ++bj)
#pragma unroll
                    for (int h = 0; h < 2; ++h) xv[m][bj][h] = __builtin_nontemporal_load((const f32x4*)(xb + (size_t)(ai * 128 + m * 16 + rr + 8 * h) * DM + colb + bj * 128 + 4 * cc));
#pragma unroll
            for (int m = 0; m < 4; ++m)
#pragma unroll
                for (int bj = 0; bj < 2; ++bj) {
                    *(LAS f32x4*)(stg + fr * 144 + (8 * fq) * 4) = acc[ai][bj][m][0];
                    *(LAS f32x4*)(stg + fr * 144 + (8 * fq + 4) * 4) = acc[ai][bj][m][1];
#pragma unroll
                    for (int h = 0; h < 2; ++h) {
                        const f32x4 y = *(const LAS f32x4*)(stg + (rr + 8 * h) * 144 + cc * 16);
                        __builtin_nontemporal_store(xv[m][bj][h] + y, (f32x4*)(ob + (size_t)(ai * 128 + m * 16 + rr + 8 * h) * DM + colb + bj * 128 + 4 * cc));
                    }
                }
        }
    }
};

struct Params {
    const float *xp, *xs, *norm_g, *w_in, *qg, *kg, *rel_bias, *w_four, *w_out;
    float* out; unsigned char* ws;
};

DI void p0_transpose_item(const float* W, int ldw, int col0, const float* gain, bf16_t* WTrow0, int K, int k0, LAS float* scr, int lane) {
    float tv[32];
#pragma unroll
    for (int i = 0; i < 32; ++i) { const int kk = 2 * i + (lane >> 5); tv[i] = W[(size_t)(k0 + kk) * ldw + col0 + (lane & 31)]; }
#pragma unroll
    for (int i = 0; i < 32; ++i) { const int kk = 2 * i + (lane >> 5); float v = tv[i]; if (gain) v *= gain[k0 + kk]; scr[kk * 33 + (lane & 31)] = v; }
    LDS_WAIT();
    const int c = lane & 7;
#pragma unroll
    for (int j = 0; j < 4; ++j) { const int n = (lane >> 3) + 8 * j; const LAS float* s = scr + (8 * c) * 33 + n;
        u32x4 o; o.x = pk2(s[0 * 33], s[1 * 33]); o.y = pk2(s[2 * 33], s[3 * 33]); o.z = pk2(s[4 * 33], s[5 * 33]); o.w = pk2(s[6 * 33], s[7 * 33]);
        *(u32x4*)(WTrow0 + (size_t)n * K + k0 + 8 * c) = o; }
    LDS_WAIT();
}
DI int t5_bucket(int rel) {
    const int n = rel < 0 ? -rel : rel; int b = rel > 0 ? 16 : 0;
    if (n < 8) return b + n;
    int large = 8 + (int)((logf((float)n / 8.0f) / 4.852030263919617f) * 8.0f);
    if (large > 15) large = 15;
    return b + large;
}
DI void p0_prologue(const Params& P, LAS unsigned char* lds) {
    const int tid = fresh_tid(), lane = tid & 63, wave = __builtin_amdgcn_readfirstlane(tid >> 6);
    const int G = gridDim.x, bx = blockIdx.x;
    unsigned char* ws = P.ws;
    bf16_t* WIN = (bf16_t*)(ws + WS_WIN); bf16_t* WOUT = (bf16_t*)(ws + WS_WOUT);
    for (int bt = bx; bt < 267; bt += G) {
        if (bt < 256) {
            const int g = bt >> 6, part = (bt >> 5) & 1, kc = (bt >> 2) & 7, eq = bt & 3;
            LAS float* Mg = (LAS float*)lds;
            LAS float* tab = (LAS float*)(lds + 4096);
            LAS float* wf = (LAS float*)(lds + 4352);
            LAS float* wi = (LAS float*)(lds + 8448);
            if (tid < 64) { float s, c; sincospif((float)tid * (2.0f / 64.0f), &s, &c); tab[tid] = part ? -s : c; }
            if (tid < 256) { const int m = tid >> 2, e4 = tid & 3; *(LAS f32x4*)(wf + m * 16 + 4 * e4) = *(const f32x4*)(P.w_four + (size_t)g * 4096 + m * 64 + 16 * eq + 4 * e4); }
#pragma unroll
            for (int i = 0; i < 4; ++i) { const int q = tid + 512 * i, kr_ = q >> 4, c4 = q & 15; const f32x4 v = *(const f32x4*)(P.w_in + (size_t)(128 * kc + kr_) * WIN_LD + 3072 + 64 * g + 4 * c4);
                LAS float* d = wi + kr_ * 65 + 4 * c4; d[0] = v[0]; d[1] = v[1]; d[2] = v[2]; d[3] = v[3]; }
            __syncthreads();
#pragma unroll
            for (int i = 0; i < 2; ++i) { const int idx = tid + 512 * i, c = idx >> 4, el = idx & 15; float a = 0.f;
#pragma unroll 8
                for (int m = 0; m < 64; ++m) a += tab[(c * m) & 63] * wf[m * 16 + el];
                Mg[c * 16 + el] = a * 0.125f; }
            __syncthreads();
            const int el = tid & 15, kq = tid >> 4, e = 16 * eq + el;
            const int prow = (12 + part) * 256 + 128 * (e >> 5) + 32 * g + (e & 31);
            float r4[4];
#pragma unroll
            for (int i = 0; i < 4; ++i) { const int kl = 4 * kq + i; const LAS float* wr_ = wi + kl * 65; float a = 0.f;
#pragma unroll 8
                for (int c = 0; c < 64; ++c) a += wr_[c] * Mg[c * 16 + el];
                r4[i] = a * P.norm_g[128 * kc + kl]; }
            *(u32x2*)(WIN + (size_t)prow * DM + 128 * kc + 4 * kq) = (u32x2){pk2(r4[0], r4[1]), pk2(r4[2], r4[3])};
            __syncthreads();
        } else if (bt < 264) {
            bf16_t* F = (bf16_t*)(ws + WS_F1P); const float sc = 0.011048543456039806f;
            for (int idx = (bt - 256) * 8192 + tid; idx < (bt - 255) * 8192; idx += 512) { const int m = idx >> 8, k = idx & 255, k1 = m >> 1, po = m & 1, s1 = k >> 1, pi = k & 1;
                float s, c; sincospif((float)((k1 * s1) & 127) * (2.0f / 128.0f), &s, &c);
                const float v = (po == pi) ? c : (po ? -s : s);
                F[idx] = (bf16_t)(pk2(v * sc, 0.f) & 0xffffu); }
        } else if (bt == 264) {
            bf16_t* F = (bf16_t*)(ws + WS_F1S); const float sc = 0.015625f;
            for (int idx = tid; idx < 16384; idx += 512) { const int m = idx >> 7, k = idx & 127, k1 = m >> 1, po = m & 1, s1 = k >> 1, pi = k & 1;
                float s, c; sincospif((float)((k1 * s1) & 63) * (2.0f / 64.0f), &s, &c);
                const float v = (po == pi) ? c : (po ? -s : s);
                F[idx] = (bf16_t)(pk2(v * sc, 0.f) & 0xffffu); }
        } else if (bt == 265) {
            bf16_t* F = (bf16_t*)(ws + WS_F2);
            for (int idx = tid; idx < 8192; idx += 512) { const int k2 = idx >> 7, k = idx & 127, s2 = k >> 1, pi = k & 1;
                float s, c; sincospif((float)((k2 * s2) & 63) * (2.0f / 64.0f), &s, &c);
                F[idx] = (bf16_t)(pk2(pi ? s : c, 0.f) & 0xffffu); }
            float2* TP = (float2*)(ws + WS_TWP); float2* TS = (float2*)(ws + WS_TWS);
            for (int n = tid; n < 8192; n += 512) { float s, c; sincospif((float)n * (2.0f / 8192.0f), &s, &c); TP[n] = make_float2(c, s); }
            for (int n = tid; n < 4096; n += 512) { float s, c; sincospif((float)n * (2.0f / 4096.0f), &s, &c); TS[n] = make_float2(c, s); }
        } else {
            float mq = 0.f, mk = 0.f, mb = 0.f;
            for (int i = 0; i < 64; ++i) { mq = fmaxf(mq, fabsf(P.qg[i])); mk = fmaxf(mk, fabsf(P.kg[i])); }
            for (int i = 0; i < 384; ++i) mb = fmaxf(mb, fabsf(P.rel_bias[i]));
            const float off2 = (8.0f * mq * mk + mb) * LOG2E;
            float* TB = (float*)(ws + WS_TB);
            for (int idx = tid; idx < 3 * 12 * 192; idx += 512) { const int p = idx / (12 * 192), h = (idx / 192) % 12, ri = idx % 192, rel = ri - 96;
                const int dil = (p == 0) ? 1 : (p == 1 ? 4 : 16);
                float v = -1e30f;
                if (rel >= -64 && rel <= 64) v = P.rel_bias[t5_bucket(rel * dil) * 12 + h] * LOG2E - off2;
                TB[idx] = v; }
        }
    }
    __syncthreads();
    const int vcu = (G % 8 == 0) ? (bx % 8) * (G / 8) + bx / 8 : bx;
    const int gw = vcu * 8 + wave, NGW = G * 8;
    LAS float* scr = (LAS float*)(lds + wave * 16384);
    constexpr int I_IN = 13 * 8 * 16, I_OUT = 32 * 16;
    for (int it = gw; it < I_IN + I_OUT; it += NGW) {
        if (it < I_IN) { const int kb = it & 15, nb8 = (it >> 4) & 7, ti = it >> 7;
            const int pn = ti < 12 ? ti : 14; const int bj = nb8 >> 2, wc = nb8 & 3; const int lt0 = 64 * wc + 32 * bj;
            const int col0 = (pn < 12 ? 256 * pn : 3328) + lt0;
            p0_transpose_item(P.w_in, WIN_LD, col0, P.norm_g, WIN + (size_t)(pn * 256 + nb8 * 32) * DM, DM, kb * 64, scr, lane);
        } else { const int r = it - I_IN; const int kb = r & 15, nb = r >> 4;
            p0_transpose_item(P.w_out, DM, nb * 32, nullptr, WOUT + (size_t)(nb * 32) * DM, DM, kb * 64, scr, lane); }
    }
    bf16_t* H = (bf16_t*)(ws + WS_H);
    for (int m = gw; m < NTOK; m += 2 * NGW) {
        const int m2 = m + NGW;
        const bool has2 = m2 < NTOK;
        const float* xr0 = (m < NPT) ? P.xp + (size_t)m * DM : P.xs + (size_t)(m - NPT) * DM;
        const int m2c = has2 ? m2 : m;
        const float* xr1 = (m2c < NPT) ? P.xp + (size_t)m2c * DM : P.xs + (size_t)(m2c - NPT) * DM;
        const f32x4* x40 = (const f32x4*)xr0 + lane; const f32x4* x41 = (const f32x4*)xr1 + lane; f32x4 v0[4], v1[4]; float s0 = 0.f, s1 = 0.f;
#pragma unroll
        for (int j = 0; j < 4; ++j) { v0[j] = __builtin_nontemporal_load(x40 + 64 * j); v1[j] = __builtin_nontemporal_load(x41 + 64 * j); }
#pragma unroll
        for (int j = 0; j < 4; ++j) { s0 += (v0[j][0] * v0[j][0] + v0[j][1] * v0[j][1]) + (v0[j][2] * v0[j][2] + v0[j][3] * v0[j][3]);
                                      s1 += (v1[j][0] * v1[j][0] + v1[j][1] * v1[j][1]) + (v1[j][2] * v1[j][2] + v1[j][3] * v1[j][3]); }
        const float rs0 = 1.0f / sqrtf(wave_sum(s0) * (1.0f / 1024.0f) + RMS_EPS), rs1 = 1.0f / sqrtf(wave_sum(s1) * (1.0f / 1024.0f) + RMS_EPS);
        u32x2* o80 = (u32x2*)(H + (size_t)m * DM) + lane; u32x2* o81 = (u32x2*)(H + (size_t)m2c * DM) + lane;
#pragma unroll
        for (int j = 0; j < 4; ++j) __builtin_nontemporal_store((u32x2){pk2(v0[j][0] * rs0, v0[j][1] * rs0), pk2(v0[j][2] * rs0, v0[j][3] * rs0)}, o80 + 64 * j);
        if (has2) {
#pragma unroll
            for (int j = 0; j < 4; ++j) __builtin_nontemporal_store((u32x2){pk2(v1[j][0] * rs1, v1[j][1] * rs1), pk2(v1[j][2] * rs1, v1[j][3] * rs1)}, o81 + 64 * j);
        }
    }
}

DI int crow(int r, int hi) { return (r & 3) + 8 * (r >> 2) + 4 * hi; }
DI s16x4 vtr(LAS const unsigned char* p) { return __builtin_bit_cast(s16x4, __builtin_amdgcn_ds_read_tr16_b64_v4i16((LAS v4i16_t*)p)); }
constexpr int AY_O = 0, AY_L = 65536, AY_TB = 67584, AY_TBC = 784  , AY_TBP = 4 * 784  , AY_STG = 76992, AY_STGW = 4096;
struct ASeq { size_t base; int dil, L; };
DI void ay_load_tile(const bf16_t* K, const bf16_t* V, const ASeq& s, int mstart, int lane, bf16x8 (&kr)[4], u32x4 (&vr)[4]) {
    const int r32 = lane & 31, hi = lane >> 5;
    int mk = mstart + r32; mk = mk < 0 ? 0 : (mk >= s.L ? s.L - 1 : mk);
    const bf16_t* kp = K + s.base + (size_t)(mk * s.dil) * 64 + 8 * hi;
#pragma unroll
    for (int sd = 0; sd < 4; ++sd) kr[sd] = *(const bf16x8*)(kp + 16 * sd);
    if (mstart >= 0 && mstart + 32 <= s.L) {
        const bf16_t* vp = V + s.base + (size_t)((mstart + (lane >> 3)) * s.dil) * 64 + (lane & 7) * 8; const size_t st = (size_t)(8 * s.dil) * 64;
#pragma unroll
        for (int i = 0; i < 4; ++i) vr[i] = *(const u32x4*)(vp + i * st);
    } else {
#pragma unroll
        for (int i = 0; i < 4; ++i) { int m = mstart + (lane >> 3) + 8 * i; m = m < 0 ? 0 : (m >= s.L ? s.L - 1 : m);
            vr[i] = *(const u32x4*)(V + s.base + (size_t)(m * s.dil) * 64 + (lane & 7) * 8); }
    }
}
DI void ay_store_tile(LAS unsigned char* stg, int lane, const u32x4 (&vr)[4]) {
#pragma unroll
    for (int i = 0; i < 4; ++i) { const int row = (lane >> 3) + 8 * i, ch = lane & 7;
        *(LAS u32x4*)(stg + row * 128 + ((ch ^ (((row >> 1) & 1) << 2)) << 4)) = vr[i]; }
}
DI void ay_load_q(const bf16_t* Q, const ASeq& s, int m, int hi, bf16x8 (&q)[4]) {
    const size_t off = s.base + (size_t)(m * s.dil) * 64 + 8 * hi;
#pragma unroll
    for (int sd = 0; sd < 4; ++sd) q[sd] = *(const bf16x8*)(Q + off + 16 * sd);
}
DI void ay_tile(LAS const unsigned char* stg, LAS const unsigned char* TBP, int ktl, bool valid, const bf16x8 (&kf)[4], const bf16x8 (&qr)[4], f32x16& o0, f32x16& o1, float& lsum, int lane) {
    const int r32 = lane & 31, hi = lane >> 5, q4 = (lane & 15) >> 2, g1 = (lane >> 4) & 1, p3 = lane & 3;
    f32x16 s;
    if (valid) {
        const LAS unsigned char* tp = TBP + (r32 & 3) * AY_TBC + (32 * ktl + 4 * hi + 32 - (r32 & ~3)) * 4;
#pragma unroll
        for (int g = 0; g < 4; ++g) { const f32x4 t = *(const LAS f32x4*)(tp + 32 * g); s[4 * g] = t[0]; s[4 * g + 1] = t[1]; s[4 * g + 2] = t[2]; s[4 * g + 3] = t[3]; }
    } else {
#pragma unroll
        for (int i = 0; i < 16; ++i) s[i] = -1e30f;
    }
#pragma unroll
    for (int sd = 0; sd < 4; ++sd) s = __builtin_amdgcn_mfma_f32_32x32x16_bf16(kf[sd], qr[sd], s, 0, 0, 0);
    float ps = 0.f;
#pragma unroll
    for (int i = 0; i < 16; ++i) { s[i] = __builtin_amdgcn_exp2f(s[i]); ps += s[i]; }
    lsum += ps;
    bf16x8 pb[2];
#pragma unroll
    for (int sk = 0; sk < 2; ++sk) { u32x4 t; t.x = pk2(s[8 * sk], s[8 * sk + 1]); t.y = pk2(s[8 * sk + 2], s[8 * sk + 3]); t.z = pk2(s[8 * sk + 4], s[8 * sk + 5]); t.w = pk2(s[8 * sk + 6], s[8 * sk + 7]); pb[sk] = __builtin_bit_cast(bf16x8, t); }
#pragma unroll
    for (int sk = 0; sk < 2; ++sk) {
        const int vrow = 16 * sk + 4 * hi + q4; const int vsw = ((vrow >> 1) & 1) << 2;
#pragma unroll
        for (int dt = 0; dt < 2; ++dt) {
            const int chunk = (4 * dt + 2 * g1 + (p3 >> 1)) ^ vsw;
            const LAS unsigned char* vp = stg + vrow * 128 + (chunk << 4) + 8 * (p3 & 1);
            const s16x4 lo = vtr(vp), hi4 = vtr(vp + 8 * 128);
            const bf16x8 vf = (bf16x8){lo[0], lo[1], lo[2], lo[3], hi4[0], hi4[1], hi4[2], hi4[3]};
            if (dt == 0) o0 = __builtin_amdgcn_mfma_f32_32x32x16_bf16(vf, pb[sk], o0, 0, 0, 0);
            else o1 = __builtin_amdgcn_mfma_f32_32x32x16_bf16(vf, pb[sk], o1, 0, 0, 0);
        }
    }
}
template <bool ACCUM>
DI void ay_accum(LAS unsigned char* lds, const f32x16& o0, const f32x16& o1, float lsum, int rowbase, int rowstride, int lane) {
    const int r32 = lane & 31, hi = lane >> 5; int row = rowbase + r32 * rowstride;
    asm volatile("" : "+v"(row));
    const int hs = ((row >> 1) ^ (row >> 5)) & 15;
    LAS unsigned char* rp = lds + AY_O + row * 128;
    lsum += __shfl_xor(lsum, 32);
#pragma unroll
    for (int dt = 0; dt < 2; ++dt)
#pragma unroll
        for (int g = 0; g < 4; ++g) {
            const int c8 = 8 * dt + 2 * g + hi; LAS u32x2* p = (LAS u32x2*)(rp + ((c8 ^ hs) << 3));
            float v0 = dt ? o1[4 * g] : o0[4 * g], v1 = dt ? o1[4 * g + 1] : o0[4 * g + 1], v2 = dt ? o1[4 * g + 2] : o0[4 * g + 2], v3 = dt ? o1[4 * g + 3] : o0[4 * g + 3];
            if (ACCUM) { const u32x2 old = *p; v0 += bflo(old.x); v1 += bfhi(old.x); v2 += bflo(old.y); v3 += bfhi(old.y); }
            *p = (u32x2){pk2(v0, v1), pk2(v2, v3)};
        }
    if (hi == 0) { LAS float* lp = (LAS float*)(lds + AY_L) + row; *lp = ACCUM ? (*lp + lsum) : lsum; }
}
struct AChunk { int valid, h, S, tokb, c0; size_t base; };
DI AChunk ay_get_chunk(int i) {
    const int G = gridDim.x, bx = blockIdx.x; AChunk a; a.valid = 0; a.h = 0; a.S = 4096; a.tokb = 0; a.c0 = 0; a.base = 0;
    int id;
    if (G == 256) { if (i >= 6) return a; const int vcu = (bx & 7) * 32 + (bx >> 3), x = vcu >> 5, c = vcu & 31;
        id = (i < 3) ? ((6 * x + 2 * i + (c >> 4)) * 16 + (c & 15)) : (768 + (12 * x + 4 * (i - 3) + (c >> 3)) * 8 + (c & 7)); }
    else id = i * G + bx;
    if (id >= 1536) return a;
    int b, h, ck, S, tokb;
    if (id < 768) { const int pair = id >> 4; ck = id & 15; b = pair / 12; h = pair % 12; S = 8192; tokb = b * 8192; }
    else { const int id2 = id - 768; const int pair = id2 >> 3; ck = id2 & 7; b = pair / 12; h = pair % 12; S = 4096; tokb = NPT + b * 4096; }
    a.valid = 1; a.h = h; a.S = S; a.tokb = tokb; a.c0 = ck * 512; a.base = ((size_t)tokb * 12 + (size_t)h * S) * 64;
    return a;
}
DI void attn_chunks(const Params& P, LAS unsigned char* lds, int i_lo, int i_hi) {
    unsigned char* ws = P.ws; unsigned char* dob = (unsigned char*)P.out;
    const bf16_t* Q = (const bf16_t*)(dob + DO_Q); const bf16_t* K = (const bf16_t*)(dob + DO_K);
    const bf16_t* V = (const bf16_t*)(ws + WS_V); const bf16_t* GA = (const bf16_t*)(ws + WS_GA);
    bf16_t* MIX = (bf16_t*)(ws + WS_H); const float* TB = (const float*)(ws + WS_TB);
    const int tid = fresh_tid(), lane = tid & 63, w = __builtin_amdgcn_readfirstlane(tid >> 6), r32 = lane & 31, hi = lane >> 5;
    LAS unsigned char* stg = lds + AY_STG + w * AY_STGW;
    bf16x8 kr[4]; u32x4 vr[4];
    for (int ci = i_lo; ci < i_hi; ++ci) {
        const AChunk ck = ay_get_chunk(ci);
        if (!ck.valid) break;
        const int S = ck.S;
        const ASeq s1{ck.base, 1, S};                         const int m1 = ck.c0 + 64 * w;
        const ASeq s2{ck.base + (size_t)(w >> 1) * 64, 4, S / 4};  const int m2 = ck.c0 / 4 + 64 * (w & 1);
        const ASeq s3a{ck.base + (size_t)(2 * w) * 64, 16, S / 16}, s3b{ck.base + (size_t)(2 * w + 1) * 64, 16, S / 16}; const int m3 = ck.c0 / 16;
        __syncthreads();
        for (int t = tid; t < 3 * 4 * 196; t += 512) { const int p = t / 784, a = (t / 196) & 3, x = t % 196; const int j = x - a;
            ((LAS float*)(lds + AY_TB))[t] = (j >= 0 && j < 192) ? TB[p * (12 * 192) + ck.h * 192 + j] : 0.f; }
        ay_load_tile(K, V, s1, m1 - 64, lane, kr, vr);
        bf16x8 qa[4], qb[4], kf[4];
        ay_load_q(Q, s1, m1 + r32, hi, qa); ay_load_q(Q, s1, m1 + 32 + r32, hi, qb);
        __syncthreads();
#define AY_TAKE() do { ay_store_tile(stg, lane, vr); _Pragma("unroll") for (int sd_ = 0; sd_ < 4; ++sd_) kf[sd_] = kr[sd_]; } while (0)
        {
            f32x16 oa0, oa1, ob0, ob1; float la = 0.f, lb = 0.f;
#pragma unroll
            for (int i = 0; i < 16; ++i) { oa0[i] = 0.f; oa1[i] = 0.f; ob0[i] = 0.f; ob1[i] = 0.f; }
#pragma unroll 1
            for (int kt = 0; kt < 6; ++kt) {
                AY_TAKE();
                if (kt < 5) ay_load_tile(K, V, s1, m1 - 64 + 32 * (kt + 1), lane, kr, vr); else ay_load_tile(K, V, s2, m2 - 64, lane, kr, vr);
                const int ms = m1 - 64 + 32 * kt; const bool valid = (ms >= 0 && ms < s1.L);
                if (kt < 5) ay_tile(stg, lds + AY_TB, kt, valid, kf, qa, oa0, oa1, la, lane);
                __builtin_amdgcn_sched_barrier(0);
                if (kt > 0) ay_tile(stg, lds + AY_TB, kt - 1, valid, kf, qb, ob0, ob1, lb, lane);
                __builtin_amdgcn_sched_barrier(0);
            }
            ay_accum<false>(lds, oa0, oa1, la, 64 * w, 1, lane);
            ay_accum<false>(lds, ob0, ob1, lb, 64 * w + 32, 1, lane);
        }
        ay_load_q(Q, s2, m2 + r32, hi, qa); ay_load_q(Q, s2, m2 + 32 + r32, hi, qb);
        __syncthreads();
        {
            f32x16 oa0, oa1, ob0, ob1; float la = 0.f, lb = 0.f;
#pragma unroll
            for (int i = 0; i < 16; ++i) { oa0[i] = 0.f; oa1[i] = 0.f; ob0[i] = 0.f; ob1[i] = 0.f; }
#pragma unroll 1
            for (int kt = 0; kt < 6; ++kt) {
                AY_TAKE();
                if (kt < 5) ay_load_tile(K, V, s2, m2 - 64 + 32 * (kt + 1), lane, kr, vr); else ay_load_tile(K, V, s3a, m3 - 64, lane, kr, vr);
                const int ms = m2 - 64 + 32 * kt; const bool valid = (ms >= 0 && ms < s2.L);
                if (kt < 5) ay_tile(stg, lds + AY_TB + AY_TBP, kt, valid, kf, qa, oa0, oa1, la, lane);
                __builtin_amdgcn_sched_barrier(0);
                if (kt > 0) ay_tile(stg, lds + AY_TB + AY_TBP, kt - 1, valid, kf, qb, ob0, ob1, lb, lane);
                __builtin_amdgcn_sched_barrier(0);
            }
            ay_accum<true>(lds, oa0, oa1, la, 4 * (64 * (w & 1)) + (w >> 1), 4, lane);
            ay_accum<true>(lds, ob0, ob1, lb, 4 * (64 * (w & 1) + 32) + (w >> 1), 4, lane);
        }
        ay_load_q(Q, s3a, m3 + r32, hi, qa); ay_load_q(Q, s3b, m3 + r32, hi, qb);
        __syncthreads();
        {
            f32x16 oa0, oa1; float la = 0.f;
#pragma unroll
            for (int i = 0; i < 16; ++i) { oa0[i] = 0.f; oa1[i] = 0.f; }
#pragma unroll 1
            for (int kt = 0; kt < 5; ++kt) {
                AY_TAKE();
                if (kt < 4) ay_load_tile(K, V, s3a, m3 - 64 + 32 * (kt + 1), lane, kr, vr); else ay_load_tile(K, V, s3b, m3 - 64, lane, kr, vr);
                const int ms = m3 - 64 + 32 * kt; const bool valid = (ms >= 0 && ms < s3a.L);
                ay_tile(stg, lds + AY_TB + 2 * AY_TBP, kt, valid, kf, qa, oa0, oa1, la, lane);
            }
            ay_accum<true>(lds, oa0, oa1, la, 2 * w, 16, lane);
        }
        {
            f32x16 oa0, oa1; float la = 0.f;
#pragma unroll
            for (int i = 0; i < 16; ++i) { oa0[i] = 0.f; oa1[i] = 0.f; }
#pragma unroll 1
            for (int kt = 0; kt < 5; ++kt) {
                AY_TAKE();
                if (kt < 4) ay_load_tile(K, V, s3b, m3 - 64 + 32 * (kt + 1), lane, kr, vr);
                const int ms = m3 - 64 + 32 * kt; const bool valid = (ms >= 0 && ms < s3b.L);
                ay_tile(stg, lds + AY_TB + 2 * AY_TBP, kt, valid, kf, qb, oa0, oa1, la, lane);
            }
            ay_accum<true>(lds, oa0, oa1, la, 2 * w + 1, 16, lane);
        }
#undef AY_TAKE
        __syncthreads();
        {
#pragma unroll 1
            for (int hb = 0; hb < 2; ++hb) {
            u32x4 gav[4];
#pragma unroll
            for (int i = 0; i < 4; ++i) { const int item = tid + 512 * (4 * hb + i), row = item >> 3, ch = item & 7; gav[i] = *(const u32x4*)(GA + ck.base + (size_t)(ck.c0 + row) * 64 + ch * 8); }
#pragma unroll
            for (int i = 0; i < 4; ++i) { const int item = tid + 512 * (4 * hb + i), ch = item & 7; int row = item >> 3; asm volatile("" : "+v"(row)); const int hs = ((row >> 1) ^ (row >> 5)) & 15;
                const u32x2 pa = *(const LAS u32x2*)(lds + AY_O + row * 128 + (((2 * ch) ^ hs) << 3)), pb = *(const LAS u32x2*)(lds + AY_O + row * 128 + (((2 * ch + 1) ^ hs) << 3));
                const float il = 1.0f / ((const LAS float*)(lds + AY_L))[row]; const u32x4 gg = gav[i];
                u32x4 o; o.x = pk2(bflo(pa.x) * il * bflo(gg.x), bfhi(pa.x) * il * bfhi(gg.x)); o.y = pk2(bflo(pa.y) * il * bflo(gg.y), bfhi(pa.y) * il * bfhi(gg.y));
                o.z = pk2(bflo(pb.x) * il * bflo(gg.z), bfhi(pb.x) * il * bfhi(gg.z)); o.w = pk2(bflo(pb.y) * il * bflo(gg.w), bfhi(pb.y) * il * bfhi(gg.w));
                *(u32x4*)(MIX + (size_t)(ck.tokb + ck.c0 + row) * DM + ck.h * 64 + ch * 8) = o; }
            }
        }
    }
    __syncthreads();
}

constexpr int FF_DATA = 0, FF_STG = 65536, FF_STGW = 9216;
struct FSrc { const bf16_t* p; int row_stride, part_off, cpr_shift; };
DI void fft_fetch(const FSrc& s, int tid, u32x4 (&t)[8]) {
#pragma unroll
    for (int i = 0; i < 8; ++i) { const int c = tid + 512 * i, row = c >> s.cpr_shift, cc = c & ((1 << s.cpr_shift) - 1);
        t[i] = *(const u32x4*)(s.p + (size_t)(row >> 1) * s.row_stride + (row & 1) * s.part_off + cc * 8); }
}
template <int K>
DI void fft_commit(LAS unsigned char* lds, int cpr_shift, int tid, const u32x4 (&t)[8]) {
#pragma unroll
    for (int i = 0; i < 8; ++i) { const int c = tid + 512 * i, row = c >> cpr_shift, cc = c & ((1 << cpr_shift) - 1), img = cc >> 4, ch = cc & 15;
        *(LAS u32x4*)(lds + FF_DATA + img * (K * 256) + row * 256 + ((ch ^ (((row & 3) << 2) | ((row >> 2) & 3))) << 4)) = t[i]; }
}
constexpr int FF_TAB = 139264;
template <int M, int K, int N, int MODE>
DI void fft_compute(LAS unsigned char* lds, int tabofs  , bf16_t* Out, const float2* TW, const bf16_t* GF,
                    int tokbase, int aux  , int N1, int colbase) {
    constexpr int NTW = N / 128;
    const int tid = fresh_tid(), lane = tid & 63, w = __builtin_amdgcn_readfirstlane(tid >> 6);
    const int g = lane >> 4, i16 = lane & 15, q4 = i16 >> 2, p3 = i16 & 3;
    LAS float* stg = (LAS float*)(lds + FF_STG + w * FF_STGW);
    constexpr int SP = 16 * NTW + 4;
    constexpr int CH = 2 * NTW;
#pragma unroll 1
    for (int mg = 0; mg < M / 64; ++mg) {
        u32x4 gfv[CH];
        if (MODE == 1) {
#pragma unroll
            for (int it = 0; it < CH; ++it) { const int idx = lane + 64 * it, rr = idx / CH, cc = idx % CH; const int tok = tokbase + aux + N1 * (64 * mg + rr);
                gfv[it] = *(const u32x4*)(GF + (size_t)tok * 256 + colbase + 16 * NTW * w + 8 * cc); }
        }
        float2 tw[4][2];
        if (MODE == 0) {
#pragma unroll
            for (int mi = 0; mi < 4; ++mi) { const int k1 = 32 * mg + 8 * mi + 2 * g; tw[mi][0] = TW[aux * k1]; tw[mi][1] = TW[aux * (k1 + 1)]; }
        }
        f32x4 acc[4][NTW];
#pragma unroll
        for (int mi = 0; mi < 4; ++mi)
#pragma unroll
            for (int ni = 0; ni < NTW; ++ni) acc[mi][ni] = (f32x4){0.f, 0.f, 0.f, 0.f};
        constexpr int AMASK = (MODE == 0 ? K / 2 : 64) - 1;
        const LAS unsigned* tabw = (const LAS unsigned*)(lds + FF_TAB) + tabofs;
#pragma unroll 4
        for (int ks = 0; ks < K / 32; ++ks) {
            bf16x8 a[4], b[NTW];
#pragma unroll
            for (int mi = 0; mi < 4; ++mi) { const int mrow = 64 * mg + 16 * mi + i16; const int kk = (MODE == 0) ? (mrow >> 1) : mrow;
                const LAS unsigned* tb = tabw + ((MODE == 0) ? (mrow & 1) * (AMASK + 1) : 0);
                const int i0 = kk * (16 * ks + 4 * g);
                u32x4 wv; wv.x = tb[i0 & AMASK]; wv.y = tb[(i0 + kk) & AMASK]; wv.z = tb[(i0 + 2 * kk) & AMASK]; wv.w = tb[(i0 + 3 * kk) & AMASK];
                a[mi] = __builtin_bit_cast(bf16x8, wv); }
#pragma unroll
            for (int ni = 0; ni < NTW; ++ni) {
                const int n0 = 16 * (NTW * w + ni), img = n0 >> 7, chb = ((n0 & 127) >> 3) + (p3 >> 1);
                const int row0 = 32 * ks + 8 * g + q4, row1 = row0 + 4;
                const LAS unsigned char* base = lds + FF_DATA + img * (K * 256) + 8 * (p3 & 1);
                const s16x4 lo = vtr(base + row0 * 256 + ((chb ^ (((row0 & 3) << 2) | ((row0 >> 2) & 3))) << 4));
                const s16x4 hi4 = vtr(base + row1 * 256 + ((chb ^ (((row1 & 3) << 2) | ((row1 >> 2) & 3))) << 4));
                b[ni] = (bf16x8){lo[0], lo[1], lo[2], lo[3], hi4[0], hi4[1], hi4[2], hi4[3]};
            }
#pragma unroll
            for (int mi = 0; mi < 4; ++mi)
#pragma unroll
                for (int ni = 0; ni < NTW; ++ni) acc[mi][ni] = __builtin_amdgcn_mfma_f32_16x16x32_bf16(a[mi], b[ni], acc[mi][ni], 0, 0, 0);
        }
#pragma unroll
        for (int mi = 0; mi < 4; ++mi)
#pragma unroll
            for (int ni = 0; ni < NTW; ++ni) {
                f32x4 v = acc[mi][ni];
                if (MODE == 0) {
                    const float2 t0 = tw[mi][0], t1 = tw[mi][1];
                    const float r0 = v[0] * t0.x + v[1] * t0.y, i0 = v[1] * t0.x - v[0] * t0.y;
                    const float r1 = v[2] * t1.x + v[3] * t1.y, i1 = v[3] * t1.x - v[2] * t1.y;
                    v = (f32x4){r0, i0, r1, i1};
                }
#pragma unroll
                for (int reg = 0; reg < 4; ++reg) stg[(16 * mi + 4 * g + reg) * SP + 16 * ni + i16] = v[reg];
            }
        LDS_WAIT();
#pragma unroll
        for (int it = 0; it < CH; ++it) {
            const int idx = lane + 64 * it, rr = idx / CH, cc = idx % CH;
            const f32x4 x0 = *(const LAS f32x4*)(stg + rr * SP + 8 * cc), x1 = *(const LAS f32x4*)(stg + rr * SP + 8 * cc + 4);
            const int m = 64 * mg + rr; const int col = colbase + 16 * NTW * w + 8 * cc;
            if (MODE == 0) {
                const int k1 = m >> 1, part = m & 1;
                bf16_t* dst = Out + (size_t)(tokbase + k1 * 64 + aux) * 512 + part * 256 + col;
                *(u32x4*)dst = (u32x4){pk2(x0[0], x0[1]), pk2(x0[2], x0[3]), pk2(x1[0], x1[1]), pk2(x1[2], x1[3])};
            } else {
                const int tok = tokbase + aux + N1 * m;
                const u32x4 gg = gfv[it];
                bf16_t* dst = Out + (size_t)tok * DM + DATT + col;
                *(u32x4*)dst = (u32x4){pk2(x0[0] * bflo(gg.x), x0[1] * bfhi(gg.x)), pk2(x0[2] * bflo(gg.y), x0[3] * bfhi(gg.y)),
                                       pk2(x1[0] * bflo(gg.z), x1[1] * bfhi(gg.z)), pk2(x1[2] * bflo(gg.w), x1[3] * bfhi(gg.w))};
            }
        }
        LDS_WAIT();
    }
}
DI FSrc fft1_src(const bf16_t* Z, int it) {
    FSrc s; s.row_stride = 64 * 512; s.part_off = 256;
    if (it < 512) { const int half = it & 1, s2 = (it >> 1) & 63, b = it >> 7; s.p = Z + (size_t)(b * 8192 + s2) * 512 + half * 128; s.cpr_shift = 4; }
    else { const int j = it - 512, s2 = j & 63, b = j >> 6; s.p = Z + (size_t)(NPT + b * 4096 + s2) * 512; s.cpr_shift = 5; }
    return s;
}
DI void fft_stage1(const Params& P, LAS unsigned char* lds) {
    const int G = gridDim.x, bx = blockIdx.x; unsigned char* ws = P.ws; const int tid = fresh_tid();
    bf16_t* Y = (bf16_t*)((unsigned char*)P.out + DO_Z); const bf16_t* Z = Y;
    { LAS unsigned* tabw = (LAS unsigned*)(lds + FF_TAB);
      if (tid < 256) { const int po = tid >> 7, idx = tid & 127; tabw[tid] = *(const unsigned*)((const bf16_t*)(ws + WS_F1P) + (2 + po) * 256 + 2 * idx); }
      else if (tid < 384) { const int q = tid - 256, po = q >> 6, idx = q & 63; tabw[tid] = *(const unsigned*)((const bf16_t*)(ws + WS_F1S) + (2 + po) * 128 + 2 * idx); } }
    u32x4 t[8];
    int it = bx;
    if (it < 1024) fft_fetch(fft1_src(Z, it), tid, t);
    for (; it < 1024; it += G) {
        __syncthreads();
        if (it < 512) fft_commit<256>(lds, 4, tid, t); else fft_commit<128>(lds, 5, tid, t);
        __syncthreads();
        if (it + G < 1024) fft_fetch(fft1_src(Z, it + G), tid, t);
        if (it < 512) { const int half = it & 1, s2 = (it >> 1) & 63, b = it >> 7;
            fft_compute<256, 256, 128, 0>(lds, 0, Y, (const float2*)(ws + WS_TWP), nullptr, b * 8192, s2, 128, half * 128);
        } else { const int j = it - 512, s2 = j & 63, b = j >> 6;
            fft_compute<128, 128, 256, 0>(lds, 256, Y, (const float2*)(ws + WS_TWS), nullptr, NPT + b * 4096, s2, 64, 0); }
    }
    __syncthreads();
}
DI FSrc fft2_src(const bf16_t* Y, int it) {
    FSrc s; s.row_stride = 512; s.part_off = 256; s.cpr_shift = 5;
    if (it < 512) { const int b = it >> 7, k1 = it & 127; s.p = Y + (size_t)(b * 8192 + k1 * 64) * 512; }
    else { const int j = it - 512, b = j >> 6, k1 = j & 63; s.p = Y + (size_t)(NPT + b * 4096 + k1 * 64) * 512; }
    return s;
}
DI void fft_stage2(const Params& P, LAS unsigned char* lds) {
    const int G = gridDim.x, bx = blockIdx.x; unsigned char* ws = P.ws; const int tid = fresh_tid();
    const bf16_t* Y = (const bf16_t*)((unsigned char*)P.out + DO_Z); bf16_t* MIX = (bf16_t*)(ws + WS_H); const bf16_t* GF = (const bf16_t*)(ws + WS_GF);
    if (tid < 64) ((LAS unsigned*)(lds + FF_TAB))[tid] = *(const unsigned*)((const bf16_t*)(ws + WS_F2) + 128 + 2 * tid);
    u32x4 t[8];
    int it = bx;
    if (it < 1024) fft_fetch(fft2_src(Y, it), tid, t);
    for (; it < 1024; it += G) {
        __syncthreads();
        fft_commit<128>(lds, 5, tid, t);
        __syncthreads();
        if (it + G < 1024) fft_fetch(fft2_src(Y, it + G), tid, t);
        int tokb, k1, N1;
        if (it < 512) { const int b = it >> 7; k1 = it & 127; tokb = b * 8192; N1 = 128; }
        else { const int j = it - 512, b = j >> 6; k1 = j & 63; tokb = NPT + b * 4096; N1 = 64; }
        fft_compute<64, 128, 256, 1>(lds, 0, MIX, nullptr, GF, tokb, k1, N1, 0);
    }
    __syncthreads();
}

#define XB_TMO      128
#define XB_XCNT(j)  (256  + 64 * (j))
#define XB_XSUB(j)  (1280 + 64 * (j))
#define XB_XGEN(j)  (2304 + 64 * (j))
#define XB_TOP      3328
#define XB_TOPGEN   3392
#define XCD_BAR_WORDS 3456
#define XB_SPIN_CAP (1u << 18)
DI unsigned xb_ld(unsigned* p)              { return __hip_atomic_load(p, __ATOMIC_RELAXED, __HIP_MEMORY_SCOPE_AGENT); }
DI unsigned xb_add(unsigned* p, unsigned v) { return __hip_atomic_fetch_add(p, v, __ATOMIC_RELAXED, __HIP_MEMORY_SCOPE_AGENT); }
DI unsigned xb_xcc_id() { return (unsigned)__builtin_amdgcn_s_getreg((3 << 11) | 20) & 0xFu; }
#define XB_SPIN(cond, bar) do { unsigned _sp = 0; while (cond) { __builtin_amdgcn_s_sleep(1); \
    if ((++_sp & 255u) == 0u) { if (xb_ld(&(bar)[XB_TMO])) break; if (_sp > XB_SPIN_CAP) { atomicAdd(&(bar)[XB_TMO], 1u); break; } } } } while (0)
struct XcdBarrier { unsigned* bar; unsigned x; volatile LAS unsigned* st; };
DI XcdBarrier xcd_barrier_post(unsigned* bar, volatile LAS unsigned* st) {
    XcdBarrier b; b.bar = bar; b.x = xb_xcc_id(); b.st = st;
    if (threadIdx.x == 0) (void)xb_add(&bar[XB_XCNT(b.x)], 1u);
    return b;
}
DI void xcd_barrier_complete(unsigned* bar, unsigned x, unsigned& nloc, unsigned& nx) {
    const unsigned G = gridDim.x * gridDim.y * gridDim.z;
    unsigned sum, cnt, mine, sp = 0u;
    for (;;) {
        sum = 0u; cnt = 0u; mine = 0u;
#pragma unroll
        for (unsigned j = 0; j < 16; ++j) { const unsigned c = xb_ld(&bar[XB_XCNT(j)]); sum += c; cnt += (c > 0u) ? 1u : 0u; mine = (j == x) ? c : mine; }
        if (sum == G) break;
        __builtin_amdgcn_s_sleep(1);
        if ((++sp & 255u) == 0u) { if (xb_ld(&bar[XB_TMO])) break; if (sp > XB_SPIN_CAP) { atomicAdd(&bar[XB_TMO], 1u); break; } }
    }
    nloc = mine > 0u ? mine : 1u; nx = cnt > 0u ? cnt : 1u;
}
DI void xcd_barrier(const XcdBarrier& b) {
    asm volatile("s_waitcnt vmcnt(0)" ::: "memory");
    __syncthreads();
    if (threadIdx.x == 0) {
        unsigned* bar = b.bar;
        __builtin_amdgcn_s_waitcnt(0);
        unsigned nloc = b.st[0], nx = b.st[1];
        if (nloc == 0u) { xcd_barrier_complete(bar, b.x, nloc, nx); b.st[0] = nloc; b.st[1] = nx; }
        const unsigned old = xb_add(&bar[XB_XSUB(b.x)], 1u);
        const unsigned gen = old / nloc;
        if (old + 1u == (gen + 1u) * nloc) {
            __builtin_amdgcn_fence(__ATOMIC_RELEASE, "agent");
            asm volatile("s_waitcnt vmcnt(0)" ::: "memory");
            const unsigned og = xb_add(&bar[XB_TOP], 1u);
            const unsigned tg = og / nx;
            if (og + 1u == (tg + 1u) * nx) xb_add(&bar[XB_TOPGEN], 1u);
            else XB_SPIN(xb_ld(&bar[XB_TOPGEN]) == tg, bar);
            __builtin_amdgcn_fence(__ATOMIC_ACQUIRE, "agent");
            xb_add(&bar[XB_XGEN(b.x)], 1u);
            asm volatile("s_waitcnt vmcnt(0)" ::: "memory");
        } else {
            XB_SPIN(xb_ld(&bar[XB_XGEN(b.x)]) == gen, bar);
            __builtin_amdgcn_fence(__ATOMIC_ACQUIRE, "agent");
            asm volatile("s_waitcnt vmcnt(0)" ::: "memory");
        }
    }
    __syncthreads();
}

constexpr int LDS_BYTES = 163840;
constexpr int EPI_STG = 131072;
constexpr int NPHASE = 8;
template <int LO, int HI, bool COOP>
__global__ void __launch_bounds__(512, 2) mk_fwd(Params P) {
    extern __shared__ __attribute__((aligned(16))) unsigned char lds_raw[];
    LAS unsigned char* lds = (LAS unsigned char*)lds_raw;
    const int G = gridDim.x;
#define IN(k) (LO <= (k) && (k) < HI)
#define SEAM(k) do { if constexpr (COOP && IN(k) && IN((k) + 1)) { xcd_barrier(xbar); } } while (0)
    unsigned char* ws = P.ws; unsigned char* dob = (unsigned char*)P.out;
    XcdBarrier xbar; xbar.bar = (unsigned*)(ws + WS_CTL); xbar.x = 0; xbar.st = (volatile LAS unsigned*)(lds + LDS_BYTES - 256);
    if constexpr (COOP) {
        if (threadIdx.x < 2) xbar.st[threadIdx.x] = 0u;
        __syncthreads();
        xbar = xcd_barrier_post(xbar.bar, xbar.st);
        if (P.ws == nullptr) cg::this_grid().sync();
    }
    if constexpr (IN(0)) { p0_prologue(P, lds); __syncthreads(); SEAM(0); }
    if constexpr (IN(1)) {
        pg8::Gemm g{(const bf16_t*)(ws + WS_H), (const bf16_t*)(ws + WS_WIN), NTOK, NPROJ, DM};
        pg8::StaticOrder S; S.init(NTOK, NPROJ, G, (int)blockIdx.x);
        EpiInProj E{(bf16_t*)(dob + DO_Q), (bf16_t*)(dob + DO_K), (bf16_t*)(ws + WS_V), (bf16_t*)(ws + WS_GA), (bf16_t*)(dob + DO_Z), (bf16_t*)(ws + WS_GF), P.qg, P.kg};
        pg8::gemm_phase<EpiInProj, pg8::StaticOrder, true, true>(lds, g, S, E);
        SEAM(1);
    }
    if constexpr (IN(2)) { fft_stage1(P, lds); }
    if constexpr (IN(3)) { attn_chunks(P, lds, 0, (G == 256) ? 3 : (1536 + 2 * G - 1) / (2 * G)); SEAM(3); }
    if constexpr (IN(4)) { fft_stage2(P, lds); }
    if constexpr (IN(5)) { attn_chunks(P, lds, (G == 256) ? 3 : (1536 + 2 * G - 1) / (2 * G), (G == 256) ? 6 : (1536 + G - 1) / G); }
    if constexpr (IN(6)) { SEAM(6); }
    if constexpr (IN(7)) {
        pg8::Gemm g{(const bf16_t*)(ws + WS_H), (const bf16_t*)(ws + WS_WOUT), NTOK, DM, DM};
        pg8::StaticOrder S; S.init(NTOK, DM, G, (int)blockIdx.x, 1);
        EpiOut E{P.xp, P.xs, P.out, lds + EPI_STG};
        pg8::gemm_phase<EpiOut, pg8::StaticOrder, true, true>(lds, g, S, E);
    }
#undef IN
#undef SEAM
}

#ifndef MK_PROBE
#define MK_PROBE -1
#endif
extern "C" void kernel_launch(void* const* d_in, const int* in_sizes, int n_in, void* d_out, int out_size, void* d_ws, size_t ws_size, hipStream_t stream) {
    static int grid = 0;
    auto kfn = mk_fwd<0, NPHASE, true>;
    if (grid == 0) {
        if (n_in != 9 || in_sizes[0] != NPT * DM || in_sizes[1] != NPT * DM || out_size != NTOK * DM || ws_size < WS_END) {
            fprintf(stderr, "kernel_launch: unexpected shapes (n_in %d, out %d, ws %zu); nothing launched\n", n_in, out_size, ws_size); grid = -1; return; }
        int dev = 0, cus = 0, per_cu = 0;
        if (hipGetDevice(&dev) != hipSuccess || hipDeviceGetAttribute(&cus, hipDeviceAttributeMultiprocessorCount, dev) != hipSuccess) { grid = -1; return; }
        if (hipFuncSetAttribute((const void*)kfn, hipFuncAttributeMaxDynamicSharedMemorySize, LDS_BYTES) != hipSuccess) { fprintf(stderr, "kernel_launch: hipFuncSetAttribute failed\n"); grid = -1; return; }
        if (hipOccupancyMaxActiveBlocksPerMultiprocessor(&per_cu, (const void*)kfn, 512, LDS_BYTES) != hipSuccess || per_cu < 1) { fprintf(stderr, "kernel_launch: occupancy query failed (%d)\n", per_cu); grid = -1; return; }
        grid = cus * 1;
    }
    if (grid < 0) return;
    Params p{};
    p.xp = (const float*)d_in[0]; p.xs = (const float*)d_in[1]; p.norm_g = (const float*)d_in[2]; p.w_in = (const float*)d_in[3];
    p.qg = (const float*)d_in[4]; p.kg = (const float*)d_in[5]; p.rel_bias = (const float*)d_in[6]; p.w_four = (const float*)d_in[7]; p.w_out = (const float*)d_in[8];
    p.out = (float*)d_out; p.ws = (unsigned char*)d_ws;
#if MK_PROBE >= 0
#define LP(LO, HI) do { static bool at_ = false; auto k_ = mk_fwd<LO, HI, false>; if (!at_) { (void)hipFuncSetAttribute((const void*)k_, hipFuncAttributeMaxDynamicSharedMemorySize, LDS_BYTES); at_ = true; } \
        hipLaunchKernelGGL(k_, dim3(grid), dim3(512), LDS_BYTES, stream, p); } while (0)
    LP(0, 1); if (MK_PROBE == 0) LP(0, 1);
    LP(1, 2); if (MK_PROBE == 1) LP(1, 2);
    if (MK_PROBE == 5) LP(5, 6);
    if (MK_PROBE == 6) LP(6, 7);
    LP(2, 3);
    LP(3, 4); if (MK_PROBE == 3) LP(3, 4);
    LP(4, 5); if (MK_PROBE == 4) LP(4, 5);
    LP(5, 6); LP(6, 7);
    LP(7, 8); if (MK_PROBE == 7) LP(7, 8);
#else
    if (hipMemsetAsync((char*)d_ws + WS_CTL, 0, XCD_BAR_WORDS * 4, stream) != hipSuccess) { fprintf(stderr, "kernel_launch: hipMemsetAsync failed\n"); return; }
    void* args[] = {&p};
    const hipError_t e = hipLaunchCooperativeKernel((const void*)kfn, dim3(grid), dim3(512), args, LDS_BYTES, stream);
    if (e != hipSuccess) fprintf(stderr, "kernel_launch: cooperative launch failed: %s (grid %d)\n", hipGetErrorString(e), grid);
#endif
}
```

```cpp
#include <hip/hip_runtime.h>
#include <hip/hip_cooperative_groups.h>
#include <cstdio>
#include <cstdint>
namespace cg = cooperative_groups;

#define DI __device__ __forceinline__
#define LAS __attribute__((address_space(3)))
typedef unsigned short bf16_t;
typedef short bf16x8 __attribute__((ext_vector_type(8)));
typedef short s16x4 __attribute__((ext_vector_type(4)));
typedef float f32x4 __attribute__((ext_vector_type(4)));
typedef float f32x16 __attribute__((ext_vector_type(16)));
typedef unsigned u32x4 __attribute__((ext_vector_type(4)));
typedef unsigned u32x2 __attribute__((ext_vector_type(2)));
typedef float f32x2_t __attribute__((ext_vector_type(2)));
typedef __bf16 bf16x2_t __attribute__((ext_vector_type(2)));
typedef short v4i16_t __attribute__((ext_vector_type(4)));

DI unsigned pk2(float lo, float hi) { f32x2_t v = {lo, hi}; bf16x2_t b = __builtin_convertvector(v, bf16x2_t); return __builtin_bit_cast(unsigned, b); }
DI float bflo(unsigned u) { return __uint_as_float(u << 16); }
DI float bfhi(unsigned u) { return __uint_as_float(u & 0xffff0000u); }
DI float silu_f(float v) { return v * __frcp_rn(1.0f + __expf(-v)); }
DI float wave_sum(float v) {
#pragma unroll
    for (int o = 1; o < 64; o <<= 1) v += __shfl_xor(v, o);
    return v;
}
#define LDS_WAIT() asm volatile("s_waitcnt lgkmcnt(0)" ::: "memory")
DI int fresh_tid() { int t = threadIdx.x; asm volatile("" : "+v"(t)); return t; }

constexpr int NTOK = 65536, NPT = 32768, DM = 1024, DATT = 768, NPROJ = 3840, WIN_LD = 3584;
constexpr float RMS_EPS = 1e-6f;
constexpr float LOG2E = 1.4426950408889634f;
constexpr float C2 = 0.125f * LOG2E;

constexpr size_t MiB = 1u << 20;
constexpr size_t WS_CTL = 0;
constexpr size_t WS_WIN = 2 * MiB;
constexpr size_t WS_WOUT = 10 * MiB;
constexpr size_t WS_F1P = 12 * MiB;
constexpr size_t WS_F1S = WS_F1P + 131072;
constexpr size_t WS_F2 = WS_F1S + 32768;
constexpr size_t WS_TWP = WS_F2 + 16384;
constexpr size_t WS_TWS = WS_TWP + 65536;
constexpr size_t WS_TB = WS_TWS + 32768;
constexpr size_t WS_H = 16 * MiB;
constexpr size_t WS_V = 144 * MiB;
constexpr size_t WS_GA = 240 * MiB;
constexpr size_t WS_GF = 336 * MiB;
constexpr size_t WS_PO = 368 * MiB;
constexpr size_t WS_L = 464 * MiB;
constexpr size_t WS_END = 468 * MiB;
constexpr size_t DO_Q = 0, DO_K = 96 * MiB, DO_Z = 192 * MiB;

namespace pg8 {
#define PG8_LAS __attribute__((address_space(3)))
constexpr int BM = 256, BK = 64, HALF = 128, HTB = HALF * BK * 2, STAGE_BYTES = 8 * HTB, NXCD = 8, WGM = 8;
__host__ __device__ __forceinline__ int lds_byte(int r, int c) { const int st = (r >> 4) * 2 + (c >> 5), rr = r & 15, cc = c & 31, ob = rr * 64 + cc * 2; return st * 1024 + (ob ^ (((ob >> 9) & 1) << 5)); }
__host__ __device__ __forceinline__ void stage_rc(int b, int& R, int& C) { const int st = b / 1024, sb = b % 1024, swz = sb ^ (((sb >> 9) & 1) << 5); R = (st >> 1) * 16 + swz / 64; C = (st & 1) * 32 + (swz % 64) / 2; }
__host__ __device__ __forceinline__ int perm32(int rho) { const int n = rho >> 4, i = rho & 15; return 8 * (i >> 2) + 4 * n + (i & 3); }
struct Unit { int pm, pn; };
struct Gemm { const bf16_t* A; const bf16_t* Bt; int M, N, K; };
struct StaticOrder {
    int nM, nN, nwg, G, c, flip;
    __host__ __device__ void init(int M, int N, int G_, int c_, int flip_ = 0) { nM = M / BM; nN = N / BM; nwg = nM * nN; G = G_; c = c_; flip = flip_; }
    __host__ __device__ bool next(int i, Unit& u) const {
        const long L = (long)i * G + c; if (L >= nwg) return false;
        int wgid = (int)L; { const int q = nwg / NXCD, r = nwg % NXCD, xcd = wgid % NXCD, off = wgid / NXCD; wgid = (xcd < r ? xcd * (q + 1) : r * (q + 1) + (xcd - r) * q) + off; }
        const int nig = WGM * nN, gid = wgid / nig, fm = gid * WGM, gsz = (nM - fm) < WGM ? (nM - fm) : WGM;
        u.pm = fm + ((wgid % nig) % gsz); u.pn = (wgid % nig) / gsz; if (flip) u.pm = nM - 1 - u.pm; return true;
    }
    __device__ __forceinline__ void a_ready(const Unit&) const {}
    __device__ __forceinline__ void done(const Unit&) const {}
};
template <class Epi, class Sched, bool ALIGN_EPI = false, bool SP2 = false>
__device__ __forceinline__ void gemm_phase(PG8_LAS unsigned char* lds, const Gemm g, const Sched& S, const Epi& E) {
    const int tid = fresh_tid(), wid = __builtin_amdgcn_readfirstlane(tid >> 6), lane = tid & 63, wr = wid >> 2, wc = wid & 3, fr = lane & 15, fq = lane >> 4;
    const int K = g.K, nt = K / BK;
    unsigned voffA[2], voffB[2];
#pragma unroll
    for (int i = 0; i < 2; ++i) { int R, C; stage_rc(tid * 16 + i * 8192, R, C); const int Rb = Epi::PERM ? ((R & ~31) + perm32(R & 31)) : R;
        voffA[i] = (unsigned)(R * K + C) * 2u; voffB[i] = (unsigned)(Rb * K + C) * 2u; }
    const size_t kstep = (size_t)(BK * 2);
    const size_t hstep = (size_t)HALF * K * 2;
    const size_t tstep = 2 * hstep;
    const unsigned ldsw = (unsigned)wid * 1024u;
    const int aoff = lds_byte(wr * 64 + fr, fq * 8), boff = lds_byte(wc * 32 + fr, fq * 8);
#define PG8_SA(b, h) (((b) * 2 + (h)) * HTB)
#define PG8_SB(b, h) ((4 + (b) * 2 + (h)) * HTB)
#define PG8_STAGE(bufoff, gbase, voff) do { _Pragma("unroll") for (int _i = 0; _i < 2; ++_i) \
        __builtin_amdgcn_global_load_lds((const unsigned*)((const char*)(gbase) + (voff)[_i]), (PG8_LAS unsigned*)(lds + (bufoff) + ldsw + _i * 8192), 16, 0, 0); } while (0)
#define PG8_LDA(dst, b, h) do { _Pragma("unroll") for (int m = 0; m < 4; ++m) _Pragma("unroll") for (int k = 0; k < 2; ++k) dst[m][k] = *(const PG8_LAS bf16x8*)(lds + PG8_SA(b, h) + aoff + m * 2048 + k * 1024); } while (0)
#define PG8_LDB(dst, b, h) do { _Pragma("unroll") for (int n = 0; n < 2; ++n) _Pragma("unroll") for (int k = 0; k < 2; ++k) dst[n][k] = *(const PG8_LAS bf16x8*)(lds + PG8_SB(b, h) + boff + n * 2048 + k * 1024); } while (0)
#define PG8_MMA(ai, bj, At, Bt) do { __builtin_amdgcn_s_setprio(1); _Pragma("unroll") for (int m = 0; m < 4; ++m) _Pragma("unroll") for (int n = 0; n < 2; ++n) _Pragma("unroll") for (int k = 0; k < 2; ++k) \
        acc[ai][bj][m][n] = __builtin_amdgcn_mfma_f32_16x16x32_bf16(Bt[n][k], At[m][k], acc[ai][bj][m][n], 0, 0, 0); __builtin_amdgcn_s_setprio(0); } while (0)
#define PG8_WAIT_V(n) asm volatile("s_waitcnt vmcnt(" #n ")" ::: "memory")
#define PG8_WAIT_L(n) asm volatile("s_waitcnt lgkmcnt(" #n ")" ::: "memory")
#define PG8_BAR __builtin_amdgcn_s_barrier()
#define PG8_SCHED __builtin_amdgcn_sched_barrier(0)
    Unit cur, nxt; int ui = 0;
    if (!S.next(0, cur)) return;
    f32x4 acc[2][2][4][2];
#pragma unroll
    for (int a = 0; a < 2; ++a)
#pragma unroll
        for (int b = 0; b < 2; ++b)
#pragma unroll
            for (int m = 0; m < 4; ++m)
#pragma unroll
                for (int n = 0; n < 2; ++n) acc[a][b][m][n] = (f32x4){0.f, 0.f, 0.f, 0.f};
    bf16x8 At[4][2], B0[2][2], B1[2][2];
    const char* cA = (const char*)g.A + (size_t)cur.pm * tstep; const char* cB = (const char*)g.Bt + (size_t)cur.pn * tstep;
    S.a_ready(cur);
    if constexpr (SP2) {
        PG8_STAGE(PG8_SB(0, 0), cB, voffB); PG8_STAGE(PG8_SB(0, 1), cB + hstep, voffB); PG8_STAGE(PG8_SA(0, 0), cA, voffA); PG8_STAGE(PG8_SA(0, 1), cA + hstep, voffA);
        if (wr == 1) PG8_BAR;
        PG8_WAIT_V(2); PG8_BAR;
        PG8_STAGE(PG8_SB(1, 0), cB + kstep, voffB); PG8_STAGE(PG8_SA(1, 0), cA + kstep, voffA); PG8_STAGE(PG8_SB(1, 1), cB + hstep + kstep, voffB);
        PG8_WAIT_V(6); PG8_BAR;
    } else {
        PG8_STAGE(PG8_SB(0, 0), cB, voffB); PG8_STAGE(PG8_SA(0, 0), cA, voffA); PG8_STAGE(PG8_SB(0, 1), cB + hstep, voffB); PG8_STAGE(PG8_SA(0, 1), cA + hstep, voffA);
        if (wr == 1) PG8_BAR;
        PG8_WAIT_V(4); PG8_BAR;
        PG8_STAGE(PG8_SB(1, 0), cB + kstep, voffB); PG8_STAGE(PG8_SA(1, 0), cA + kstep, voffA); PG8_STAGE(PG8_SB(1, 1), cB + hstep + kstep, voffB);
        PG8_WAIT_V(6); PG8_BAR;
    }
    for (;;) {
        const bool has_next = S.next(ui + 1, nxt);
        const char* nA = has_next ? (const char*)g.A + (size_t)nxt.pm * tstep : cA; const char* nB = has_next ? (const char*)g.Bt + (size_t)nxt.pn * tstep : cB;
        for (int t = 0; t < nt; t += 2) {
            const bool last = (t == nt - 2);
            const char* a1 = cA + (size_t)(t + 1) * kstep;
            const char* a2 = last ? nA : cA + (size_t)(t + 2) * kstep; const char* b2 = last ? nB : cB + (size_t)(t + 2) * kstep;
            const char* a3 = a2 + kstep; const char* b3 = b2 + kstep;
            if (last && has_next) S.a_ready(nxt);
            if constexpr (SP2) {
            PG8_LDB(B0, 0, 0); PG8_LDB(B1, 0, 1); PG8_SCHED; PG8_LDA(At, 0, 0); PG8_STAGE(PG8_SA(1, 1), a1 + hstep, voffA);
            PG8_WAIT_V(8); PG8_WAIT_L(0); PG8_BAR; PG8_MMA(0, 0, At, B0); PG8_MMA(0, 1, At, B1); PG8_BAR; PG8_SCHED;
            PG8_LDA(At, 0, 1); PG8_STAGE(PG8_SB(0, 0), b2, voffB); PG8_STAGE(PG8_SB(0, 1), b2 + hstep, voffB); PG8_STAGE(PG8_SA(0, 0), a2, voffA);
            PG8_WAIT_V(8); PG8_WAIT_L(0); PG8_BAR; PG8_MMA(1, 0, At, B0); PG8_MMA(1, 1, At, B1); PG8_BAR; PG8_SCHED;
            PG8_LDB(B0, 1, 0); PG8_LDB(B1, 1, 1); PG8_SCHED; PG8_LDA(At, 1, 0); PG8_STAGE(PG8_SA(0, 1), a2 + hstep, voffA);
            PG8_WAIT_V(8); PG8_WAIT_L(0); PG8_BAR; PG8_MMA(0, 0, At, B0); PG8_MMA(0, 1, At, B1); PG8_BAR; PG8_SCHED;
            PG8_LDA(At, 1, 1); PG8_STAGE(PG8_SB(1, 0), b3, voffB); PG8_STAGE(PG8_SB(1, 1), b3 + hstep, voffB); PG8_STAGE(PG8_SA(1, 0), a3, voffA);
            PG8_WAIT_V(8); PG8_WAIT_L(0); PG8_BAR; PG8_MMA(1, 0, At, B0); PG8_MMA(1, 1, At, B1); PG8_BAR; PG8_SCHED;
            } else {
            PG8_LDB(B0, 0, 0); PG8_SCHED; PG8_LDA(At, 0, 0); PG8_STAGE(PG8_SA(1, 1), a1 + hstep, voffA);
            PG8_WAIT_L(8); PG8_BAR; PG8_WAIT_L(0); PG8_MMA(0, 0, At, B0); PG8_BAR; PG8_SCHED;
            PG8_LDB(B1, 0, 1); PG8_STAGE(PG8_SB(0, 0), b2, voffB);
            PG8_BAR; PG8_WAIT_L(0); PG8_MMA(0, 1, At, B1); PG8_BAR;
            PG8_LDA(At, 0, 1); PG8_STAGE(PG8_SA(0, 0), a2, voffA);
            PG8_BAR; PG8_WAIT_L(0); PG8_MMA(1, 0, At, B0); PG8_BAR; PG8_SCHED;
            PG8_STAGE(PG8_SB(0, 1), b2 + hstep, voffB);
            PG8_WAIT_V(6); PG8_BAR; PG8_MMA(1, 1, At, B1); PG8_BAR;
            PG8_LDB(B0, 1, 0); PG8_SCHED; PG8_LDA(At, 1, 0); PG8_STAGE(PG8_SA(0, 1), a2 + hstep, voffA);
            PG8_WAIT_L(8); PG8_BAR; PG8_WAIT_L(0); PG8_MMA(0, 0, At, B0); PG8_BAR; PG8_SCHED;
            PG8_LDB(B1, 1, 1); PG8_STAGE(PG8_SB(1, 0), b3, voffB);
            PG8_BAR; PG8_WAIT_L(0); PG8_MMA(0, 1, At, B1); PG8_BAR;
            PG8_LDA(At, 1, 1); PG8_STAGE(PG8_SA(1, 0), a3, voffA);
            PG8_BAR; PG8_WAIT_L(0); PG8_MMA(1, 0, At, B0); PG8_BAR; PG8_SCHED;
            PG8_STAGE(PG8_SB(1, 1), b3 + hstep, voffB);
            PG8_WAIT_V(6); PG8_BAR; PG8_MMA(1, 1, At, B1); PG8_BAR;
            }
        }
        if constexpr (ALIGN_EPI) { if (wr == 0) PG8_BAR; }
        E(acc, cur, wr, wc, fr, fq); S.done(cur);
        if (!has_next) break;
#pragma unroll
        for (int a = 0; a < 2; ++a)
#pragma unroll
            for (int b = 0; b < 2; ++b)
#pragma unroll
                for (int m = 0; m < 4; ++m)
#pragma unroll
                    for (int n = 0; n < 2; ++n) acc[a][b][m][n] = (f32x4){0.f, 0.f, 0.f, 0.f};
        cur = nxt; cA = nA; cB = nB; ++ui;
        if constexpr (ALIGN_EPI) { if (wr == 1) PG8_BAR; }
    }
    PG8_WAIT_V(0);
    if constexpr (!ALIGN_EPI) { if (wr == 0) PG8_BAR; }
    PG8_BAR;
#undef PG8_SA
#undef PG8_SB
#undef PG8_STAGE
#undef PG8_LDA
#undef PG8_LDB
#undef PG8_MMA
#undef PG8_WAIT_V
#undef PG8_WAIT_L
#undef PG8_BAR
#undef PG8_SCHED
}
}

struct EpiInProj {
    static constexpr bool PERM = true;
    bf16_t *Q, *K, *V, *GA, *Z, *GF; const float *qg, *kg;
    DI void store8(bf16_t* p, const f32x4& a, const f32x4& b) const {
        u32x4 w; w.x = pk2(a[0], a[1]); w.y = pk2(a[2], a[3]); w.z = pk2(b[0], b[1]); w.w = pk2(b[2], b[3]); *(u32x4*)p = w; }
    DI size_t hm_off(int pm, int head, int srow) const {
        int tokb, S, s0;
        if (pm < 128) { tokb = (pm >> 5) * 8192; S = 8192; s0 = (pm & 31) * 256; } else { const int q = pm - 128; tokb = NPT + (q >> 4) * 4096; S = 4096; s0 = (q & 15) * 256; }
        return ((size_t)tokb * 12 + (size_t)head * S + s0 + srow) * 64;
    }
    DI void operator()(const f32x4 (&acc)[2][2][4][2], const pg8::Unit& u, int wr, int wc, int fr, int fq) const {
        const int pn = u.pn; const int row0 = u.pm * 256 + wr * 64 + fr; const int srow0 = wr * 64 + fr;
        if (pn < 6) {
            const bool isq = pn < 3; const float* g = isq ? qg : kg; const float sc = isq ? C2 : 1.0f;
            bf16_t* O = isq ? Q : K; const int head = (isq ? pn : pn - 3) * 4 + wc;
            bf16_t* ob = O + hm_off(u.pm, head, srow0) + 8 * fq;
            f32x4 gv[2][2];
#pragma unroll
            for (int bj = 0; bj < 2; ++bj)
#pragma unroll
                for (int n = 0; n < 2; ++n) { gv[bj][n] = *(const f32x4*)(g + 32 * bj + 8 * fq + 4 * n); gv[bj][n] = gv[bj][n] * sc; }
#pragma unroll
            for (int ai = 0; ai < 2; ++ai)
#pragma unroll
                for (int m = 0; m < 4; ++m) {
                    float ss = 0.f;
#pragma unroll
                    for (int bj = 0; bj < 2; ++bj)
#pragma unroll
                        for (int n = 0; n < 2; ++n) { const f32x4 v = acc[ai][bj][m][n]; ss += (v[0] * v[0] + v[1] * v[1]) + (v[2] * v[2] + v[3] * v[3]); }
                    ss += __shfl_xor(ss, 16); ss += __shfl_xor(ss, 32);
                    const float rs = 1.0f / sqrtf(ss * (1.0f / 64.0f) + RMS_EPS);
                    bf16_t* rowp = ob + (size_t)(ai * 128 + m * 16) * 64;
#pragma unroll
                    for (int bj = 0; bj < 2; ++bj) store8(rowp + 32 * bj, acc[ai][bj][m][0] * rs * gv[bj][0], acc[ai][bj][m][1] * rs * gv[bj][1]);
                }
        } else if (pn < 9) {
            const int head = (pn - 6) * 4 + wc; bf16_t* ob = V + hm_off(u.pm, head, srow0) + 8 * fq;
#pragma unroll
            for (int ai = 0; ai < 2; ++ai)
#pragma unroll
                for (int m = 0; m < 4; ++m) { bf16_t* rowp = ob + (size_t)(ai * 128 + m * 16) * 64;
#pragma unroll
                    for (int bj = 0; bj < 2; ++bj) store8(rowp + 32 * bj, acc[ai][bj][m][0], acc[ai][bj][m][1]); }
        } else if (pn < 12) {
            const int head = (pn - 9) * 4 + wc; bf16_t* ob = GA + hm_off(u.pm, head, srow0) + 8 * fq;
#pragma unroll
            for (int ai = 0; ai < 2; ++ai)
#pragma unroll
                for (int m = 0; m < 4; ++m) { bf16_t* rowp = ob + (size_t)(ai * 128 + m * 16) * 64;
#pragma unroll
                    for (int bj = 0; bj < 2; ++bj) { f32x4 a = acc[ai][bj][m][0], b = acc[ai][bj][m][1];
#pragma unroll
                        for (int i = 0; i < 4; ++i) { a[i] = silu_f(a[i]); b[i] = silu_f(b[i]); }
                        store8(rowp + 32 * bj, a, b); } }
        } else if (pn < 14) {
            const int col = (pn - 12) * 256 + wc * 64 + 8 * fq;
#pragma unroll
            for (int ai = 0; ai < 2; ++ai)
#pragma unroll
                for (int m = 0; m < 4; ++m) { bf16_t* rowp = Z + (size_t)(row0 + ai * 128 + m * 16) * 512 + col;
#pragma unroll
                    for (int bj = 0; bj < 2; ++bj) store8(rowp + 32 * bj, acc[ai][bj][m][0], acc[ai][bj][m][1]); }
        } else {
            const int col = wc * 64 + 8 * fq;
#pragma unroll
            for (int ai = 0; ai < 2; ++ai)
#pragma unroll
                for (int m = 0; m < 4; ++m) { bf16_t* rowp = GF + (size_t)(row0 + ai * 128 + m * 16) * 256 + col;
#pragma unroll
                    for (int bj = 0; bj < 2; ++bj) { f32x4 a = acc[ai][bj][m][0], b = acc[ai][bj][m][1];
#pragma unroll
                        for (int i = 0; i < 4; ++i) { a[i] = silu_f(a[i]); b[i] = silu_f(b[i]); }
                        store8(rowp + 32 * bj, a, b); } }
        }
    }
};
struct EpiOut {
    static constexpr bool PERM = true;
    const float *xp, *xs; float* out; LAS unsigned char* stgbase;
    DI void operator()(const f32x4 (&acc)[2][2][4][2], const pg8::Unit& u, int wr, int wc, int fr, int fq) const {
        LAS unsigned char* stg = stgbase + (wr * 4 + wc) * 4096;
        const int lane = fq * 16 + fr, rr = lane >> 3, cc = lane & 7;
        const int rowb = u.pm * 256 + wr * 64, colb = u.pn * 256 + wc * 32;
        const float* xb = (u.pm < 128) ? xp + (size_t)rowb * DM : xs + (size_t)(rowb - NPT) * DM;
        float* ob = out + (size_t)rowb * DM;
#pragma unroll
        for (int ai = 0; ai < 2; ++ai) {
            f32x4 xv[4][2][2];
#pragma unroll
            for (int m = 0; m < 4; ++m)
#pragma unroll
                for (int bj = 0; bj < 2; ++bj)
#pragma unroll
                    for (int h = 0; h < 2; ++h) xv[m][bj][h] = __builtin_nontemporal_load((const f32x4*)(xb + (size_t)(ai * 128 + m * 16 + rr + 8 * h) * DM + colb + bj * 128 + 4 * cc));
#pragma unroll
            for (int m = 0; m < 4; ++m)
#pragma unroll
                for (int bj = 0; bj < 2; ++bj) {
                    *(LAS f32x4*)(stg + fr * 144 + (8 * fq) * 4) = acc[ai][bj][m][0];
                    *(LAS f32x4*)(stg + fr * 144 + (8 * fq + 4) * 4) = acc[ai][bj][m][1];
#pragma unroll
                    for (int h = 0; h < 2; ++h) {
                        const f32x4 y = *(const LAS f32x4*)(stg + (rr + 8 * h) * 144 + cc * 16);
                        __builtin_nontemporal_store(xv[m][bj][h] + y, (f32x4*)(ob + (size_t)(ai * 128 + m * 16 + rr + 8 * h) * DM + colb + bj * 128 + 4 * cc));
                    }
                }
        }
    }
};

struct Params {
    const float *xp, *xs, *norm_g, *w_in, *qg, *kg, *rel_bias, *w_four, *w_out;
    float* out; unsigned char* ws;
};

DI void p0_transpose_item(const float* W, int ldw, int col0, const float* gain, bf16_t* WTrow0, int K, int k0, LAS float* scr, int lane) {
    float tv[32];
#pragma unroll
    for (int i = 0; i < 32; ++i) { const int kk = 2 * i + (lane >> 5); tv[i] = W[(size_t)(k0 + kk) * ldw + col0 + (lane & 31)]; }
#pragma unroll
    for (int i = 0; i < 32; ++i) { const int kk = 2 * i + (lane >> 5); float v = tv[i]; if (gain) v *= gain[k0 + kk]; scr[kk * 33 + (lane & 31)] = v; }
    LDS_WAIT();
    const int c = lane & 7;
#pragma unroll
    for (int j = 0; j < 4; ++j) { const int n = (lane >> 3) + 8 * j; const LAS float* s = scr + (8 * c) * 33 + n;
        u32x4 o; o.x = pk2(s[0 * 33], s[1 * 33]); o.y = pk2(s[2 * 33], s[3 * 33]); o.z = pk2(s[4 * 33], s[5 * 33]); o.w = pk2(s[6 * 33], s[7 * 33]);
        *(u32x4*)(WTrow0 + (size_t)n * K + k0 + 8 * c) = o; }
    LDS_WAIT();
}
DI int t5_bucket(int rel) {
    const int n = rel < 0 ? -rel : rel; int b = rel > 0 ? 16 : 0;
    if (n < 8) return b + n;
    int large = 8 + (int)((logf((float)n / 8.0f) / 4.852030263919617f) * 8.0f);
    if (large > 15) large = 15;
    return b + large;
}
DI void p0_prologue(const Params& P, LAS unsigned char* lds) {
    const int tid = fresh_tid(), lane = tid & 63, wave = __builtin_amdgcn_readfirstlane(tid >> 6);
    const int G = gridDim.x, bx = blockIdx.x;
    unsigned char* ws = P.ws;
    bf16_t* WIN = (bf16_t*)(ws + WS_WIN); bf16_t* WOUT = (bf16_t*)(ws + WS_WOUT);
    for (int bt = bx; bt < 267; bt += G) {
        if (bt < 256) {
            const int g = bt >> 6, part = (bt >> 5) & 1, kc = (bt >> 2) & 7, eq = bt & 3;
            LAS float* Mg = (LAS float*)lds;
            LAS float* tab = (LAS float*)(lds + 4096);
            LAS float* wf = (LAS float*)(lds + 4352);
            LAS float* wi = (LAS float*)(lds + 8448);
            if (tid < 64) { float s, c; sincospif((float)tid * (2.0f / 64.0f), &s, &c); tab[tid] = part ? -s : c; }
            if (tid < 256) { const int m = tid >> 2, e4 = tid & 3; *(LAS f32x4*)(wf + m * 16 + 4 * e4) = *(const f32x4*)(P.w_four + (size_t)g * 4096 + m * 64 + 16 * eq + 4 * e4); }
#pragma unroll
            for (int i = 0; i < 4; ++i) { const int q = tid + 512 * i, kr_ = q >> 4, c4 = q & 15; const f32x4 v = *(const f32x4*)(P.w_in + (size_t)(128 * kc + kr_) * WIN_LD + 3072 + 64 * g + 4 * c4);
                LAS float* d = wi + kr_ * 65 + 4 * c4; d[0] = v[0]; d[1] = v[1]; d[2] = v[2]; d[3] = v[3]; }
            __syncthreads();
#pragma unroll
            for (int i = 0; i < 2; ++i) { const int idx = tid + 512 * i, c = idx >> 4, el = idx & 15; float a = 0.f;
#pragma unroll 8
                for (int m = 0; m < 64; ++m) a += tab[(c * m) & 63] * wf[m * 16 + el];
                Mg[c * 16 + el] = a * 0.125f; }
            __syncthreads();
            const int el = tid & 15, kq = tid >> 4, e = 16 * eq + el;
            const int prow = (12 + part) * 256 + 128 * (e >> 5) + 32 * g + (e & 31);
            float r4[4];
#pragma unroll
            for (int i = 0; i < 4; ++i) { const int kl = 4 * kq + i; const LAS float* wr_ = wi + kl * 65; float a = 0.f;
#pragma unroll 8
                for (int c = 0; c < 64; ++c) a += wr_[c] * Mg[c * 16 + el];
                r4[i] = a * P.norm_g[128 * kc + kl]; }
            *(u32x2*)(WIN + (size_t)prow * DM + 128 * kc + 4 * kq) = (u32x2){pk2(r4[0], r4[1]), pk2(r4[2], r4[3])};
            __syncthreads();
        } else if (bt < 264) {
            bf16_t* F = (bf16_t*)(ws + WS_F1P); const float sc = 0.011048543456039806f;
            for (int idx = (bt - 256) * 8192 + tid; idx < (bt - 255) * 8192; idx += 512) { const int m = idx >> 8, k = idx & 255, k1 = m >> 1, po = m & 1, s1 = k >> 1, pi = k & 1;
                float s, c; sincospif((float)((k1 * s1) & 127) * (2.0f / 128.0f), &s, &c);
                const float v = (po == pi) ? c : (po ? -s : s);
                F[idx] = (bf16_t)(pk2(v * sc, 0.f) & 0xffffu); }
        } else if (bt == 264) {
            bf16_t* F = (bf16_t*)(ws + WS_F1S); const float sc = 0.015625f;
            for (int idx = tid; idx < 16384; idx += 512) { const int m = idx >> 7, k = idx & 127, k1 = m >> 1, po = m & 1, s1 = k >> 1, pi = k & 1;
                float s, c; sincospif((float)((k1 * s1) & 63) * (2.0f / 64.0f), &s, &c);
                const float v = (po == pi) ? c : (po ? -s : s);
                F[idx] = (bf16_t)(pk2(v * sc, 0.f) & 0xffffu); }
        } else if (bt == 265) {
            bf16_t* F = (bf16_t*)(ws + WS_F2);
            for (int idx = tid; idx < 8192; idx += 512) { const int k2 = idx >> 7, k = idx & 127, s2 = k >> 1, pi = k & 1;
                float s, c; sincospif((float)((k2 * s2) & 63) * (2.0f / 64.0f), &s, &c);
                F[idx] = (bf16_t)(pk2(pi ? s : c, 0.f) & 0xffffu); }
            float2* TP = (float2*)(ws + WS_TWP); float2* TS = (float2*)(ws + WS_TWS);
            for (int n = tid; n < 8192; n += 512) { float s, c; sincospif((float)n * (2.0f / 8192.0f), &s, &c); TP[n] = make_float2(c, s); }
            for (int n = tid; n < 4096; n += 512) { float s, c; sincospif((float)n * (2.0f / 4096.0f), &s, &c); TS[n] = make_float2(c, s); }
        } else {
            float mq = 0.f, mk = 0.f, mb = 0.f;
            for (int i = 0; i < 64; ++i) { mq = fmaxf(mq, fabsf(P.qg[i])); mk = fmaxf(mk, fabsf(P.kg[i])); }
            for (int i = 0; i < 384; ++i) mb = fmaxf(mb, fabsf(P.rel_bias[i]));
            const float off2 = (8.0f * mq * mk + mb) * LOG2E;
            float* TB = (float*)(ws + WS_TB);
            for (int idx = tid; idx < 3 * 12 * 192; idx += 512) { const int p = idx / (12 * 192), h = (idx / 192) % 12, ri = idx % 192, rel = ri - 96;
                const int dil = (p == 0) ? 1 : (p == 1 ? 4 : 16);
                float v = -1e30f;
                if (rel >= -64 && rel <= 64) v = P.rel_bias[t5_bucket(rel * dil) * 12 + h] * LOG2E - off2;
                TB[idx] = v; }
        }
    }
    __syncthreads();
    const int vcu = (G % 8 == 0) ? (bx % 8) * (G / 8) + bx / 8 : bx;
    const int gw = vcu * 8 + wave, NGW = G * 8;
    LAS float* scr = (LAS float*)(lds + wave * 16384);
    constexpr int I_IN = 13 * 8 * 16, I_OUT = 32 * 16;
    for (int it = gw; it < I_IN + I_OUT; it += NGW) {
        if (it < I_IN) { const int kb = it & 15, nb8 = (it >> 4) & 7, ti = it >> 7;
            const int pn = ti < 12 ? ti : 14; const int bj = nb8 >> 2, wc = nb8 & 3; const int lt0 = 64 * wc + 32 * bj;
            const int col0 = (pn < 12 ? 256 * pn : 3328) + lt0;
            p0_transpose_item(P.w_in, WIN_LD, col0, P.norm_g, WIN + (size_t)(pn * 256 + nb8 * 32) * DM, DM, kb * 64, scr, lane);
        } else { const int r = it - I_IN; const int kb = r & 15, nb = r >> 4;
            p0_transpose_item(P.w_out, DM, nb * 32, nullptr, WOUT + (size_t)(nb * 32) * DM, DM, kb * 64, scr, lane); }
    }
    bf16_t* H = (bf16_t*)(ws + WS_H);
    for (int m = gw; m < NTOK; m += 2 * NGW) {
        const int m2 = m + NGW;
        const bool has2 = m2 < NTOK;
        const float* xr0 = (m < NPT) ? P.xp + (size_t)m * DM : P.xs + (size_t)(m - NPT) * DM;
        const int m2c = has2 ? m2 : m;
        const float* xr1 = (m2c < NPT) ? P.xp + (size_t)m2c * DM : P.xs + (size_t)(m2c - NPT) * DM;
        const f32x4* x40 = (const f32x4*)xr0 + lane; const f32x4* x41 = (const f32x4*)xr1 + lane; f32x4 v0[4], v1[4]; float s0 = 0.f, s1 = 0.f;
#pragma unroll
        for (int j = 0; j < 4; ++j) { v0[j] = __builtin_nontemporal_load(x40 + 64 * j); v1[j] = __builtin_nontemporal_load(x41 + 64 * j); }
#pragma unroll
        for (int j = 0; j < 4; ++j) { s0 += (v0[j][0] * v0[j][0] + v0[j][1] * v0[j][1]) + (v0[j][2] * v0[j][2] + v0[j][3] * v0[j][3]);
                                      s1 += (v1[j][0] * v1[j][0] + v1[j][1] * v1[j][1]) + (v1[j][2] * v1[j][2] + v1[j][3] * v1[j][3]); }
        const float rs0 = 1.0f / sqrtf(wave_sum(s0) * (1.0f / 1024.0f) + RMS_EPS), rs1 = 1.0f / sqrtf(wave_sum(s1) * (1.0f / 1024.0f) + RMS_EPS);
        u32x2* o80 = (u32x2*)(H + (size_t)m * DM) + lane; u32x2* o81 = (u32x2*)(H + (size_t)m2c * DM) + lane;
#pragma unroll
        for (int j = 0; j < 4; ++j) __builtin_nontemporal_store((u32x2){pk2(v0[j][0] * rs0, v0[j][1] * rs0), pk2(v0[j][2] * rs0, v0[j][3] * rs0)}, o80 + 64 * j);
        if (has2) {
#pragma unroll
            for (int j = 0; j < 4; ++j) __builtin_nontemporal_store((u32x2){pk2(v1[j][0] * rs1, v1[j][1] * rs1), pk2(v1[j][2] * rs1, v1[j][3] * rs1)}, o81 + 64 * j);
        }
    }
}

DI int crow(int r, int hi) { return (r & 3) + 8 * (r >> 2) + 4 * hi; }
DI s16x4 vtr(LAS const unsigned char* p) { return __builtin_bit_cast(s16x4, __builtin_amdgcn_ds_read_tr16_b64_v4i16((LAS v4i16_t*)p)); }
constexpr int AY_O = 0, AY_L = 65536, AY_TB = 67584, AY_TBC = 784  , AY_TBP = 4 * 784  , AY_STG = 76992, AY_STGW = 4096;
struct ASeq { size_t base; int dil, L; };
DI void ay_load_tile(const bf16_t* K, const bf16_t* V, const ASeq& s, int mstart, int lane, bf16x8 (&kr)[4], u32x4 (&vr)[4]) {
    const int r32 = lane & 31, hi = lane >> 5;
    int mk = mstart + r32; mk = mk < 0 ? 0 : (mk >= s.L ? s.L - 1 : mk);
    const bf16_t* kp = K + s.base + (size_t)(mk * s.dil) * 64 + 8 * hi;
#pragma unroll
    for (int sd = 0; sd < 4; ++sd) kr[sd] = *(const bf16x8*)(kp + 16 * sd);
    if (mstart >= 0 && mstart + 32 <= s.L) {
        const bf16_t* vp = V + s.base + (size_t)((mstart + (lane >> 3)) * s.dil) * 64 + (lane & 7) * 8; const size_t st = (size_t)(8 * s.dil) * 64;
#pragma unroll
        for (int i = 0; i < 4; ++i) vr[i] = *(const u32x4*)(vp + i * st);
    } else {
#pragma unroll
        for (int i = 0; i < 4; ++i) { int m = mstart + (lane >> 3) + 8 * i; m = m < 0 ? 0 : (m >= s.L ? s.L - 1 : m);
            vr[i] = *(const u32x4*)(V + s.base + (size_t)(m * s.dil) * 64 + (lane & 7) * 8); }
    }
}
DI void ay_store_tile(LAS unsigned char* stg, int lane, const u32x4 (&vr)[4]) {
#pragma unroll
    for (int i = 0; i < 4; ++i) { const int row = (lane >> 3) + 8 * i, ch = lane & 7;
        *(LAS u32x4*)(stg + row * 128 + ((ch ^ (((row >> 1) & 1) << 2)) << 4)) = vr[i]; }
}
DI void ay_load_q(const bf16_t* Q, const ASeq& s, int m, int hi, bf16x8 (&q)[4]) {
    const size_t off = s.base + (size_t)(m * s.dil) * 64 + 8 * hi;
#pragma unroll
    for (int sd = 0; sd < 4; ++sd) q[sd] = *(const bf16x8*)(Q + off + 16 * sd);
}
DI void ay_tile(LAS const unsigned char* stg, LAS const unsigned char* TBP, int ktl, bool valid, const bf16x8 (&kf)[4], const bf16x8 (&qr)[4], f32x16& o0, f32x16& o1, float& lsum, int lane) {
    const int r32 = lane & 31, hi = lane >> 5, q4 = (lane & 15) >> 2, g1 = (lane >> 4) & 1, p3 = lane & 3;
    f32x16 s;
    if (valid) {
        const LAS unsigned char* tp = TBP + (r32 & 3) * AY_TBC + (32 * ktl + 4 * hi + 32 - (r32 & ~3)) * 4;
#pragma unroll
        for (int g = 0; g < 4; ++g) { const f32x4 t = *(const LAS f32x4*)(tp + 32 * g); s[4 * g] = t[0]; s[4 * g + 1] = t[1]; s[4 * g + 2] = t[2]; s[4 * g + 3] = t[3]; }
    } else {
#pragma unroll
        for (int i = 0; i < 16; ++i) s[i] = -1e30f;
    }
#pragma unroll
    for (int sd = 0; sd < 4; ++sd) s = __builtin_amdgcn_mfma_f32_32x32x16_bf16(kf[sd], qr[sd], s, 0, 0, 0);
    float ps = 0.f;
#pragma unroll
    for (int i = 0; i < 16; ++i) { s[i] = __builtin_amdgcn_exp2f(s[i]); ps += s[i]; }
    lsum += ps;
    bf16x8 pb[2];
#pragma unroll
    for (int sk = 0; sk < 2; ++sk) { u32x4 t; t.x = pk2(s[8 * sk], s[8 * sk + 1]); t.y = pk2(s[8 * sk + 2], s[8 * sk + 3]); t.z = pk2(s[8 * sk + 4], s[8 * sk + 5]); t.w = pk2(s[8 * sk + 6], s[8 * sk + 7]); pb[sk] = __builtin_bit_cast(bf16x8, t); }
#pragma unroll
    for (int sk = 0; sk < 2; ++sk) {
        const int vrow = 16 * sk + 4 * hi + q4; const int vsw = ((vrow >> 1) & 1) << 2;
#pragma unroll
        for (int dt = 0; dt < 2; ++dt) {
            const int chunk = (4 * dt + 2 * g1 + (p3 >> 1)) ^ vsw;
            const LAS unsigned char* vp = stg + vrow * 128 + (chunk << 4) + 8 * (p3 & 1);
            const s16x4 lo = vtr(vp), hi4 = vtr(vp + 8 * 128);
            const bf16x8 vf = (bf16x8){lo[0], lo[1], lo[2], lo[3], hi4[0], hi4[1], hi4[2], hi4[3]};
            if (dt == 0) o0 = __builtin_amdgcn_mfma_f32_32x32x16_bf16(vf, pb[sk], o0, 0, 0, 0);
            else o1 = __builtin_amdgcn_mfma_f32_32x32x16_bf16(vf, pb[sk], o1, 0, 0, 0);
        }
    }
}
template <bool ACCUM>
DI void ay_accum(LAS unsigned char* lds, const f32x16& o0, const f32x16& o1, float lsum, int rowbase, int rowstride, int lane) {
    const int r32 = lane & 31, hi = lane >> 5; int row = rowbase + r32 * rowstride;
    asm volatile("" : "+v"(row));
    const int hs = ((row >> 1) ^ (row >> 5)) & 15;
    LAS unsigned char* rp = lds + AY_O + row * 128;
    lsum += __shfl_xor(lsum, 32);
#pragma unroll
    for (int dt = 0; dt < 2; ++dt)
#pragma unroll
        for (int g = 0; g < 4; ++g) {
            const int c8 = 8 * dt + 2 * g + hi; LAS u32x2* p = (LAS u32x2*)(rp + ((c8 ^ hs) << 3));
            float v0 = dt ? o1[4 * g] : o0[4 * g], v1 = dt ? o1[4 * g + 1] : o0[4 * g + 1], v2 = dt ? o1[4 * g + 2] : o0[4 * g + 2], v3 = dt ? o1[4 * g + 3] : o0[4 * g + 3];
            if (ACCUM) { const u32x2 old = *p; v0 += bflo(old.x); v1 += bfhi(old.x); v2 += bflo(old.y); v3 += bfhi(old.y); }
            *p = (u32x2){pk2(v0, v1), pk2(v2, v3)};
        }
    if (hi == 0) { LAS float* lp = (LAS float*)(lds + AY_L) + row; *lp = ACCUM ? (*lp + lsum) : lsum; }
}
struct AChunk { int valid, h, S, tokb, c0; size_t base; };
DI AChunk ay_get_chunk(int i) {
    const int G = gridDim.x, bx = blockIdx.x; AChunk a; a.valid = 0; a.h = 0; a.S = 4096; a.tokb = 0; a.c0 = 0; a.base = 0;
    int id;
    if (G == 256) { if (i >= 6) return a; const int vcu = (bx & 7) * 32 + (bx >> 3), x = vcu >> 5, c = vcu & 31;
        id = (i < 3) ? ((6 * x + 2 * i + (c >> 4)) * 16 + (c & 15)) : (768 + (12 * x + 4 * (i - 3) + (c >> 3)) * 8 + (c & 7)); }
    else id = i * G + bx;
    if (id >= 1536) return a;
    int b, h, ck, S, tokb;
    if (id < 768) { const int pair = id >> 4; ck = id & 15; b = pair / 12; h = pair % 12; S = 8192; tokb = b * 8192; }
    else { const int id2 = id - 768; const int pair = id2 >> 3; ck = id2 & 7; b = pair / 12; h = pair % 12; S = 4096; tokb = NPT + b * 4096; }
    a.valid = 1; a.h = h; a.S = S; a.tokb = tokb; a.c0 = ck * 512; a.base = ((size_t)tokb * 12 + (size_t)h * S) * 64;
    return a;
}
DI void attn_chunks(const Params& P, LAS unsigned char* lds, int i_lo, int i_hi) {
    unsigned char* ws = P.ws; unsigned char* dob = (unsigned char*)P.out;
    const bf16_t* Q = (const bf16_t*)(dob + DO_Q); const bf16_t* K = (const bf16_t*)(dob + DO_K);
    const bf16_t* V = (const bf16_t*)(ws + WS_V); const bf16_t* GA = (const bf16_t*)(ws + WS_GA);
    bf16_t* MIX = (bf16_t*)(ws + WS_H); const float* TB = (const float*)(ws + WS_TB);
    const int tid = fresh_tid(), lane = tid & 63, w = __builtin_amdgcn_readfirstlane(tid >> 6), r32 = lane & 31, hi = lane >> 5;
    LAS unsigned char* stg = lds + AY_STG + w * AY_STGW;
    bf16x8 kr[4]; u32x4 vr[4];
    for (int ci = i_lo; ci < i_hi; ++ci) {
        const AChunk ck = ay_get_chunk(ci);
        if (!ck.valid) break;
        const int S = ck.S;
        const ASeq s1{ck.base, 1, S};                         const int m1 = ck.c0 + 64 * w;
        const ASeq s2{ck.base + (size_t)(w >> 1) * 64, 4, S / 4};  const int m2 = ck.c0 / 4 + 64 * (w & 1);
        const ASeq s3a{ck.base + (size_t)(2 * w) * 64, 16, S / 16}, s3b{ck.base + (size_t)(2 * w + 1) * 64, 16, S / 16}; const int m3 = ck.c0 / 16;
        __syncthreads();
        for (int t = tid; t < 3 * 4 * 196; t += 512) { const int p = t / 784, a = (t / 196) & 3, x = t % 196; const int j = x - a;
            ((LAS float*)(lds + AY_TB))[t] = (j >= 0 && j < 192) ? TB[p * (12 * 192) + ck.h * 192 + j] : 0.f; }
        ay_load_tile(K, V, s1, m1 - 64, lane, kr, vr);
        bf16x8 qa[4], qb[4], kf[4];
        ay_load_q(Q, s1, m1 + r32, hi, qa); ay_load_q(Q, s1, m1 + 32 + r32, hi, qb);
        __syncthreads();
#define AY_TAKE() do { ay_store_tile(stg, lane, vr); _Pragma("unroll") for (int sd_ = 0; sd_ < 4; ++sd_) kf[sd_] = kr[sd_]; } while (0)
        {
            f32x16 oa0, oa1, ob0, ob1; float la = 0.f, lb = 0.f;
#pragma unroll
            for (int i = 0; i < 16; ++i) { oa0[i] = 0.f; oa1[i] = 0.f; ob0[i] = 0.f; ob1[i] = 0.f; }
#pragma unroll 1
            for (int kt = 0; kt < 6; ++kt) {
                AY_TAKE();
                if (kt < 5) ay_load_tile(K, V, s1, m1 - 64 + 32 * (kt + 1), lane, kr, vr); else ay_load_tile(K, V, s2, m2 - 64, lane, kr, vr);
                const int ms = m1 - 64 + 32 * kt; const bool valid = (ms >= 0 && ms < s1.L);
                if (kt < 5) ay_tile(stg, lds + AY_TB, kt, valid, kf, qa, oa0, oa1, la, lane);
                __builtin_amdgcn_sched_barrier(0);
                if (kt > 0) ay_tile(stg, lds + AY_TB, kt - 1, valid, kf, qb, ob0, ob1, lb, lane);
                __builtin_amdgcn_sched_barrier(0);
            }
            ay_accum<false>(lds, oa0, oa1, la, 64 * w, 1, lane);
            ay_accum<false>(lds, ob0, ob1, lb, 64 * w + 32, 1, lane);
        }
        ay_load_q(Q, s2, m2 + r32, hi, qa); ay_load_q(Q, s2, m2 + 32 + r32, hi, qb);
        __syncthreads();
        {
            f32x16 oa0, oa1, ob0, ob1; float la = 0.f, lb = 0.f;
#pragma unroll
            for (int i = 0; i < 16; ++i) { oa0[i] = 0.f; oa1[i] = 0.f; ob0[i] = 0.f; ob1[i] = 0.f; }
#pragma unroll 1
            for (int kt = 0; kt < 6; ++kt) {
                AY_TAKE();
                if (kt < 5) ay_load_tile(K, V, s2, m2 - 64 + 32 * (kt + 1), lane, kr, vr); else ay_load_tile(K, V, s3a, m3 - 64, lane, kr, vr);
                const int ms = m2 - 64 + 32 * kt; const bool valid = (ms >= 0 && ms < s2.L);
                if (kt < 5) ay_tile(stg, lds + AY_TB + AY_TBP, kt, valid, kf, qa, oa0, oa1, la, lane);
                __builtin_amdgcn_sched_barrier(0);
                if (kt > 0) ay_tile(stg, lds + AY_TB + AY_TBP, kt - 1, valid, kf, qb, ob0, ob1, lb, lane);
                __builtin_amdgcn_sched_barrier(0);
            }
            ay_accum<true>(lds, oa0, oa1, la, 4 * (64 * (w & 1)) + (w >> 1), 4, lane);
            ay_accum<true>(lds, ob0, ob1, lb, 4 * (64 * (w & 1) + 32) + (w >> 1), 4, lane);
        }
        ay_load_q(Q, s3a, m3 + r32, hi, qa); ay_load_q(Q, s3b, m3 + r32, hi, qb);
        __syncthreads();
        {
            f32x16 oa0, oa1; float la = 0.f;
#pragma unroll
            for (int i = 0; i < 16; ++i) { oa0[i] = 0.f; oa1[i] = 0.f; }
#pragma unroll 1
            for (int kt = 0; kt < 5; ++kt) {
                AY_TAKE();
                if (kt < 4) ay_load_tile(K, V, s3a, m3 - 64 + 32 * (kt + 1), lane, kr, vr); else ay_load_tile(K, V, s3b, m3 - 64, lane, kr, vr);
                const int ms = m3 - 64 + 32 * kt; const bool valid = (ms >= 0 && ms < s3a.L);
                ay_tile(stg, lds + AY_TB + 2 * AY_TBP, kt, valid, kf, qa, oa0, oa1, la, lane);
            }
            ay_accum<true>(lds, oa0, oa1, la, 2 * w, 16, lane);
        }
        {
            f32x16 oa0, oa1; float la = 0.f;
#pragma unroll
            for (int i = 0; i < 16; ++i) { oa0[i] = 0.f; oa1[i] = 0.f; }
#pragma unroll 1
            for (int kt = 0; kt < 5; ++kt) {
                AY_TAKE();
                if (kt < 4) ay_load_tile(K, V, s3b, m3 - 64 + 32 * (kt + 1), lane, kr, vr);
                const int ms = m3 - 64 + 32 * kt; const bool valid = (ms >= 0 && ms < s3b.L);
                ay_tile(stg, lds + AY_TB + 2 * AY_TBP, kt, valid, kf, qb, oa0, oa1, la, lane);
            }
            ay_accum<true>(lds, oa0, oa1, la, 2 * w + 1, 16, lane);
        }
#undef AY_TAKE
        __syncthreads();
        {
#pragma unroll 1
            for (int hb = 0; hb < 2; ++hb) {
            u32x4 gav[4];
#pragma unroll
            for (int i = 0; i < 4; ++i) { const int item = tid + 512 * (4 * hb + i), row = item >> 3, ch = item & 7; gav[i] = *(const u32x4*)(GA + ck.base + (size_t)(ck.c0 + row) * 64 + ch * 8); }
#pragma unroll
            for (int i = 0; i < 4; ++i) { const int item = tid + 512 * (4 * hb + i), ch = item & 7; int row = item >> 3; asm volatile("" : "+v"(row)); const int hs = ((row >> 1) ^ (row >> 5)) & 15;
                const u32x2 pa = *(const LAS u32x2*)(lds + AY_O + row * 128 + (((2 * ch) ^ hs) << 3)), pb = *(const LAS u32x2*)(lds + AY_O + row * 128 + (((2 * ch + 1) ^ hs) << 3));
                const float il = 1.0f / ((const LAS float*)(lds + AY_L))[row]; const u32x4 gg = gav[i];
                u32x4 o; o.x = pk2(bflo(pa.x) * il * bflo(gg.x), bfhi(pa.x) * il * bfhi(gg.x)); o.y = pk2(bflo(pa.y) * il * bflo(gg.y), bfhi(pa.y) * il * bfhi(gg.y));
                o.z = pk2(bflo(pb.x) * il * bflo(gg.z), bfhi(pb.x) * il * bfhi(gg.z)); o.w = pk2(bflo(pb.y) * il * bflo(gg.w), bfhi(pb.y) * il * bfhi(gg.w));
                *(u32x4*)(MIX + (size_t)(ck.tokb + ck.c0 + row) * DM + ck.h * 64 + ch * 8) = o; }
            }
        }
    }
    __syncthreads();
}

constexpr int FF_DATA = 0, FF_STG = 65536, FF_STGW = 9216;
struct FSrc { const bf16_t* p; int row_stride, part_off, cpr_shift; };
DI void fft_fetch(const FSrc& s, int tid, u32x4 (&t)[8]) {
#pragma unroll
    for (int i = 0; i < 8; ++i) { const int c = tid + 512 * i, row = c >> s.cpr_shift, cc = c & ((1 << s.cpr_shift) - 1);
        t[i] = *(const u32x4*)(s.p + (size_t)(row >> 1) * s.row_stride + (row & 1) * s.part_off + cc * 8); }
}
template <int K>
DI void fft_commit(LAS unsigned char* lds, int cpr_shift, int tid, const u32x4 (&t)[8]) {
#pragma unroll
    for (int i = 0; i < 8; ++i) { const int c = tid + 512 * i, row = c >> cpr_shift, cc = c & ((1 << cpr_shift) - 1), img = cc >> 4, ch = cc & 15;
        *(LAS u32x4*)(lds + FF_DATA + img * (K * 256) + row * 256 + ((ch ^ (((row & 3) << 2) | ((row >> 2) & 3))) << 4)) = t[i]; }
}
constexpr int FF_TAB = 139264;
template <int M, int K, int N, int MODE>
DI void fft_compute(LAS unsigned char* lds, int tabofs  , bf16_t* Out, const float2* TW, const bf16_t* GF,
                    int tokbase, int aux  , int N1, int colbase) {
    constexpr int NTW = N / 128;
    const int tid = fresh_tid(), lane = tid & 63, w = __builtin_amdgcn_readfirstlane(tid >> 6);
    const int g = lane >> 4, i16 = lane & 15, q4 = i16 >> 2, p3 = i16 & 3;
    LAS float* stg = (LAS float*)(lds + FF_STG + w * FF_STGW);
    constexpr int SP = 16 * NTW + 4;
    constexpr int CH = 2 * NTW;
#pragma unroll 1
    for (int mg = 0; mg < M / 64; ++mg) {
        u32x4 gfv[CH];
        if (MODE == 1) {
#pragma unroll
            for (int it = 0; it < CH; ++it) { const int idx = lane + 64 * it, rr = idx / CH, cc = idx % CH; const int tok = tokbase + aux + N1 * (64 * mg + rr);
                gfv[it] = *(const u32x4*)(GF + (size_t)tok * 256 + colbase + 16 * NTW * w + 8 * cc); }
        }
        float2 tw[4][2];
        if (MODE == 0) {
#pragma unroll
            for (int mi = 0; mi < 4; ++mi) { const int k1 = 32 * mg + 8 * mi + 2 * g; tw[mi][0] = TW[aux * k1]; tw[mi][1] = TW[aux * (k1 + 1)]; }
        }
        f32x4 acc[4][NTW];
#pragma unroll
        for (int mi = 0; mi < 4; ++mi)
#pragma unroll
            for (int ni = 0; ni < NTW; ++ni) acc[mi][ni] = (f32x4){0.f, 0.f, 0.f, 0.f};
        constexpr int AMASK = (MODE == 0 ? K / 2 : 64) - 1;
        const LAS unsigned* tabw = (const LAS unsigned*)(lds + FF_TAB) + tabofs;
#pragma unroll 4
        for (int ks = 0; ks < K / 32; ++ks) {
            bf16x8 a[4], b[NTW];
#pragma unroll
            for (int mi = 0; mi < 4; ++mi) { const int mrow = 64 * mg + 16 * mi + i16; const int kk = (MODE == 0) ? (mrow >> 1) : mrow;
                const LAS unsigned* tb = tabw + ((MODE == 0) ? (mrow & 1) * (AMASK + 1) : 0);
                const int i0 = kk * (16 * ks + 4 * g);
                u32x4 wv; wv.x = tb[i0 & AMASK]; wv.y = tb[(i0 + kk) & AMASK]; wv.z = tb[(i0 + 2 * kk) & AMASK]; wv.w = tb[(i0 + 3 * kk) & AMASK];
                a[mi] = __builtin_bit_cast(bf16x8, wv); }
#pragma unroll
            for (int ni = 0; ni < NTW; ++ni) {
                const int n0 = 16 * (NTW * w + ni), img = n0 >> 7, chb = ((n0 & 127) >> 3) + (p3 >> 1);
                const int row0 = 32 * ks + 8 * g + q4, row1 = row0 + 4;
                const LAS unsigned char* base = lds + FF_DATA + img * (K * 256) + 8 * (p3 & 1);
                const s16x4 lo = vtr(base + row0 * 256 + ((chb ^ (((row0 & 3) << 2) | ((row0 >> 2) & 3))) << 4));
                const s16x4 hi4 = vtr(base + row1 * 256 + ((chb ^ (((row1 & 3) << 2) | ((row1 >> 2) & 3))) << 4));
                b[ni] = (bf16x8){lo[0], lo[1], lo[2], lo[3], hi4[0], hi4[1], hi4[2], hi4[3]};
            }
#pragma unroll
            for (int mi = 0; mi < 4; ++mi)
#pragma unroll
                for (int ni = 0; ni < NTW; ++ni) acc[mi][ni] = __builtin_amdgcn_mfma_f32_16x16x32_bf16(a[mi], b[ni], acc[mi][ni], 0, 0, 0);
        }
#pragma unroll
        for (int mi = 0; mi < 4; ++mi)
#pragma unroll
            for (int ni = 0; ni < NTW; ++ni) {
                f32x4 v = acc[mi][ni];
                if (MODE == 0) {
                    const float2 t0 = tw[mi][0], t1 = tw[mi][1];
                    const float r0 = v[0] * t0.x + v[1] * t0.y, i0 = v[1] * t0.x - v[0] * t0.y;
                    const float r1 = v[2] * t1.x + v[3] * t1.y, i1 = v[3] * t1.x - v[2] * t1.y;
                    v = (f32x4){r0, i0, r1, i1};
                }
#pragma unroll
                for (int reg = 0; reg < 4; ++reg) stg[(16 * mi + 4 * g + reg) * SP + 16 * ni + i16] = v[reg];
            }
        LDS_WAIT();
#pragma unroll
        for (int it = 0; it < CH; ++it) {
            const int idx = lane + 64 * it, rr = idx / CH, cc = idx % CH;
            const f32x4 x0 = *(const LAS f32x4*)(stg + rr * SP + 8 * cc), x1 = *(const LAS f32x4*)(stg + rr * SP + 8 * cc + 4);
            const int m = 64 * mg + rr; const int col = colbase + 16 * NTW * w + 8 * cc;
            if (MODE == 0) {
                const int k1 = m >> 1, part = m & 1;
                bf16_t* dst = Out + (size_t)(tokbase + k1 * 64 + aux) * 512 + part * 256 + col;
                *(u32x4*)dst = (u32x4){pk2(x0[0], x0[1]), pk2(x0[2], x0[3]), pk2(x1[0], x1[1]), pk2(x1[2], x1[3])};
            } else {
                const int tok = tokbase + aux + N1 * m;
                const u32x4 gg = gfv[it];
                bf16_t* dst = Out + (size_t)tok * DM + DATT + col;
                *(u32x4*)dst = (u32x4){pk2(x0[0] * bflo(gg.x), x0[1] * bfhi(gg.x)), pk2(x0[2] * bflo(gg.y), x0[3] * bfhi(gg.y)),
                                       pk2(x1[0] * bflo(gg.z), x1[1] * bfhi(gg.z)), pk2(x1[2] * bflo(gg.w), x1[3] * bfhi(gg.w))};
            }
        }
        LDS_WAIT();
    }
}
template <int M, int K, int N>
DI void fft1_compute(LAS unsigned char* lds, int tabofs  , bf16_t* Out, const float2* TW, int tokbase, int s2, int colbase) {
    constexpr int MT = M / 128, NT = N / 16;
    constexpr int AMASK = K / 2 - 1;
    const int tid = fresh_tid(), lane = tid & 63, w = __builtin_amdgcn_readfirstlane(tid >> 6);
    const int g = lane >> 4, i16 = lane & 15, q4 = i16 >> 2, p3 = i16 & 3;
    LAS float* stg = (LAS float*)(lds + FF_STG + w * FF_STGW);
    const LAS unsigned* tabw = (const LAS unsigned*)(lds + FF_TAB) + tabofs;
    f32x4 acc[MT][NT];
#pragma unroll
    for (int mi = 0; mi < MT; ++mi)
#pragma unroll
        for (int ni = 0; ni < NT; ++ni) acc[mi][ni] = (f32x4){0.f, 0.f, 0.f, 0.f};
    float2 tw[MT][2];
#pragma unroll
    for (int mi = 0; mi < MT; ++mi) { const int k1 = 8 * (MT * w + mi) + 2 * g; tw[mi][0] = TW[s2 * k1]; tw[mi][1] = TW[s2 * (k1 + 1)]; }
#pragma unroll 2
    for (int ks = 0; ks < K / 32; ++ks) {
        bf16x8 a[MT];
#pragma unroll
        for (int mi = 0; mi < MT; ++mi) { const int mrow = 16 * (MT * w + mi) + i16; const int kk = mrow >> 1;
            const LAS unsigned* tb = tabw + (mrow & 1) * (AMASK + 1);
            const int i0 = kk * (16 * ks + 4 * g);
            u32x4 wv; wv.x = tb[i0 & AMASK]; wv.y = tb[(i0 + kk) & AMASK]; wv.z = tb[(i0 + 2 * kk) & AMASK]; wv.w = tb[(i0 + 3 * kk) & AMASK];
            a[mi] = __builtin_bit_cast(bf16x8, wv); }
        const int row0 = 32 * ks + 8 * g + q4, row1 = row0 + 4;
        const int x0 = ((row0 & 3) << 2) | ((row0 >> 2) & 3), x1 = ((row1 & 3) << 2) | ((row1 >> 2) & 3);
#pragma unroll
        for (int ni = 0; ni < NT; ++ni) {
            const int n0 = 16 * ni, img = n0 >> 7, chb = ((n0 & 127) >> 3) + (p3 >> 1);
            const LAS unsigned char* base = lds + FF_DATA + img * (K * 256) + 8 * (p3 & 1);
            const s16x4 lo = vtr(base + row0 * 256 + ((chb ^ x0) << 4));
            const s16x4 hi4 = vtr(base + row1 * 256 + ((chb ^ x1) << 4));
            const bf16x8 b = (bf16x8){lo[0], lo[1], lo[2], lo[3], hi4[0], hi4[1], hi4[2], hi4[3]};
#pragma unroll
            for (int mi = 0; mi < MT; ++mi) acc[mi][ni] = __builtin_amdgcn_mfma_f32_16x16x32_bf16(a[mi], b, acc[mi][ni], 0, 0, 0);
        }
    }
    constexpr int SP = 132;
#pragma unroll
    for (int mi = 0; mi < MT; ++mi)
#pragma unroll
        for (int grp = 0; grp < NT / 8; ++grp) {
#pragma unroll
            for (int n8 = 0; n8 < 8; ++n8) {
                f32x4 v = acc[mi][8 * grp + n8];
                const float2 t0 = tw[mi][0], t1 = tw[mi][1];
                const float r0 = v[0] * t0.x + v[1] * t0.y, i0_ = v[1] * t0.x - v[0] * t0.y;
                const float r1 = v[2] * t1.x + v[3] * t1.y, i1_ = v[3] * t1.x - v[2] * t1.y;
                stg[(4 * g + 0) * SP + 16 * n8 + i16] = r0; stg[(4 * g + 1) * SP + 16 * n8 + i16] = i0_;
                stg[(4 * g + 2) * SP + 16 * n8 + i16] = r1; stg[(4 * g + 3) * SP + 16 * n8 + i16] = i1_;
            }
            LDS_WAIT();
#pragma unroll
            for (int it = 0; it < 4; ++it) {
                const int rr = 4 * it + (lane >> 4), cc = lane & 15;
                const f32x4 y0 = *(const LAS f32x4*)(stg + rr * SP + 8 * cc), y1 = *(const LAS f32x4*)(stg + rr * SP + 8 * cc + 4);
                const int m = 16 * (MT * w + mi) + rr, k1 = m >> 1, part = m & 1;
                bf16_t* dst = Out + (size_t)(tokbase + k1 * 64 + s2) * 512 + part * 256 + colbase + 128 * grp + 8 * cc;
                *(u32x4*)dst = (u32x4){pk2(y0[0], y0[1]), pk2(y0[2], y0[3]), pk2(y1[0], y1[1]), pk2(y1[2], y1[3])};
            }
            LDS_WAIT();
        }
}
DI FSrc fft1_src(const bf16_t* Z, int it) {
    FSrc s; s.row_stride = 64 * 512; s.part_off = 256;
    if (it < 512) { const int half = it & 1, s2 = (it >> 1) & 63, b = it >> 7; s.p = Z + (size_t)(b * 8192 + s2) * 512 + half * 128; s.cpr_shift = 4; }
    else { const int j = it - 512, s2 = j & 63, b = j >> 6; s.p = Z + (size_t)(NPT + b * 4096 + s2) * 512; s.cpr_shift = 5; }
    return s;
}
DI void fft_stage1(const Params& P, LAS unsigned char* lds) {
    const int G = gridDim.x, bx = blockIdx.x; unsigned char* ws = P.ws; const int tid = fresh_tid();
    bf16_t* Y = (bf16_t*)((unsigned char*)P.out + DO_Z); const bf16_t* Z = Y;
    { LAS unsigned* tabw = (LAS unsigned*)(lds + FF_TAB);
      if (tid < 256) { const int po = tid >> 7, idx = tid & 127; tabw[tid] = *(const unsigned*)((const bf16_t*)(ws + WS_F1P) + (2 + po) * 256 + 2 * idx); }
      else if (tid < 384) { const int q = tid - 256, po = q >> 6, idx = q & 63; tabw[tid] = *(const unsigned*)((const bf16_t*)(ws + WS_F1S) + (2 + po) * 128 + 2 * idx); } }
    u32x4 t[8];
    int it = bx;
    if (it < 1024) fft_fetch(fft1_src(Z, it), tid, t);
    for (; it < 1024; it += G) {
        __syncthreads();
        if (it < 512) fft_commit<256>(lds, 4, tid, t); else fft_commit<128>(lds, 5, tid, t);
        __syncthreads();
        if (it + G < 1024) fft_fetch(fft1_src(Z, it + G), tid, t);
        if (it < 512) { const int half = it & 1, s2 = (it >> 1) & 63, b = it >> 7;
            fft1_compute<256, 256, 128>(lds, 0, Y, (const float2*)(ws + WS_TWP), b * 8192, s2, half * 128);
        } else { const int j = it - 512, s2 = j & 63, b = j >> 6;
            fft1_compute<128, 128, 256>(lds, 256, Y, (const float2*)(ws + WS_TWS), NPT + b * 4096, s2, 0); }
    }
    __syncthreads();
}
DI FSrc fft2_src(const bf16_t* Y, int it) {
    FSrc s; s.row_stride = 512; s.part_off = 256; s.cpr_shift = 5;
    if (it < 512) { const int b = it >> 7, k1 = it & 127; s.p = Y + (size_t)(b * 8192 + k1 * 64) * 512; }
    else { const int j = it - 512, b = j >> 6, k1 = j & 63; s.p = Y + (size_t)(NPT + b * 4096 + k1 * 64) * 512; }
    return s;
}
DI void fft_stage2(const Params& P, LAS unsigned char* lds) {
    const int G = gridDim.x, bx = blockIdx.x; unsigned char* ws = P.ws; const int tid = fresh_tid();
    const bf16_t* Y = (const bf16_t*)((unsigned char*)P.out + DO_Z); bf16_t* MIX = (bf16_t*)(ws + WS_H); const bf16_t* GF = (const bf16_t*)(ws + WS_GF);
    if (tid < 64) ((LAS unsigned*)(lds + FF_TAB))[tid] = *(const unsigned*)((const bf16_t*)(ws + WS_F2) + 128 + 2 * tid);
    u32x4 t[8];
    int it = bx;
    if (it < 1024) fft_fetch(fft2_src(Y, it), tid, t);
    for (; it < 1024; it += G) {
        __syncthreads();
        fft_commit<128>(lds, 5, tid, t);
        __syncthreads();
        if (it + G < 1024) fft_fetch(fft2_src(Y, it + G), tid, t);
        int tokb, k1, N1;
        if (it < 512) { const int b = it >> 7; k1 = it & 127; tokb = b * 8192; N1 = 128; }
        else { const int j = it - 512, b = j >> 6; k1 = j & 63; tokb = NPT + b * 4096; N1 = 64; }
        fft_compute<64, 128, 256, 1>(lds, 0, MIX, nullptr, GF, tokb, k1, N1, 0);
    }
    __syncthreads();
}

#define XB_TMO      128
#define XB_XCNT(j)  (256  + 64 * (j))
#define XB_XSUB(j)  (1280 + 64 * (j))
#define XB_XGEN(j)  (2304 + 64 * (j))
#define XB_TOP      3328
#define XB_TOPGEN   3392
#define XCD_BAR_WORDS 3456
#define XB_SPIN_CAP (1u << 18)
DI unsigned xb_ld(unsigned* p)              { return __hip_atomic_load(p, __ATOMIC_RELAXED, __HIP_MEMORY_SCOPE_AGENT); }
DI unsigned xb_add(unsigned* p, unsigned v) { return __hip_atomic_fetch_add(p, v, __ATOMIC_RELAXED, __HIP_MEMORY_SCOPE_AGENT); }
DI unsigned xb_xcc_id() { return (unsigned)__builtin_amdgcn_s_getreg((3 << 11) | 20) & 0xFu; }
#define XB_SPIN(cond, bar) do { unsigned _sp = 0; while (cond) { __builtin_amdgcn_s_sleep(1); \
    if ((++_sp & 255u) == 0u) { if (xb_ld(&(bar)[XB_TMO])) break; if (_sp > XB_SPIN_CAP) { atomicAdd(&(bar)[XB_TMO], 1u); break; } } } } while (0)
struct XcdBarrier { unsigned* bar; unsigned x; volatile LAS unsigned* st; };
DI XcdBarrier xcd_barrier_post(unsigned* bar, volatile LAS unsigned* st) {
    XcdBarrier b; b.bar = bar; b.x = xb_xcc_id(); b.st = st;
    if (threadIdx.x == 0) (void)xb_add(&bar[XB_XCNT(b.x)], 1u);
    return b;
}
DI void xcd_barrier_complete(unsigned* bar, unsigned x, unsigned& nloc, unsigned& nx) {
    const unsigned G = gridDim.x * gridDim.y * gridDim.z;
    unsigned sum, cnt, mine, sp = 0u;
    for (;;) {
        sum = 0u; cnt = 0u; mine = 0u;
#pragma unroll
        for (unsigned j = 0; j < 16; ++j) { const unsigned c = xb_ld(&bar[XB_XCNT(j)]); sum += c; cnt += (c > 0u) ? 1u : 0u; mine = (j == x) ? c : mine; }
        if (sum == G) break;
        __builtin_amdgcn_s_sleep(1);
        if ((++sp & 255u) == 0u) { if (xb_ld(&bar[XB_TMO])) break; if (sp > XB_SPIN_CAP) { atomicAdd(&bar[XB_TMO], 1u); break; } }
    }
    nloc = mine > 0u ? mine : 1u; nx = cnt > 0u ? cnt : 1u;
}
DI void xcd_barrier(const XcdBarrier& b) {
    asm volatile("s_waitcnt vmcnt(0)" ::: "memory");
    __syncthreads();
    if (threadIdx.x == 0) {
        unsigned* bar = b.bar;
        __builtin_amdgcn_s_waitcnt(0);
        unsigned nloc = b.st[0], nx = b.st[1];
        if (nloc == 0u) { xcd_barrier_complete(bar, b.x, nloc, nx); b.st[0] = nloc; b.st[1] = nx; }
        const unsigned old = xb_add(&bar[XB_XSUB(b.x)], 1u);
        const unsigned gen = old / nloc;
        if (old + 1u == (gen + 1u) * nloc) {
            __builtin_amdgcn_fence(__ATOMIC_RELEASE, "agent");
            asm volatile("s_waitcnt vmcnt(0)" ::: "memory");
            const unsigned og = xb_add(&bar[XB_TOP], 1u);
            const unsigned tg = og / nx;
            if (og + 1u == (tg + 1u) * nx) xb_add(&bar[XB_TOPGEN], 1u);
            else XB_SPIN(xb_ld(&bar[XB_TOPGEN]) == tg, bar);
            __builtin_amdgcn_fence(__ATOMIC_ACQUIRE, "agent");
            xb_add(&bar[XB_XGEN(b.x)], 1u);
            asm volatile("s_waitcnt vmcnt(0)" ::: "memory");
        } else {
            XB_SPIN(xb_ld(&bar[XB_XGEN(b.x)]) == gen, bar);
            __builtin_amdgcn_fence(__ATOMIC_ACQUIRE, "agent");
            asm volatile("s_waitcnt vmcnt(0)" ::: "memory");
        }
    }
    __syncthreads();
}

constexpr int LDS_BYTES = 163840;
constexpr int EPI_STG = 131072;
constexpr int NPHASE = 8;
template <int LO, int HI, bool COOP>
__global__ void __launch_bounds__(512, 2) mk_fwd(Params P) {
    extern __shared__ __attribute__((aligned(16))) unsigned char lds_raw[];
    LAS unsigned char* lds = (LAS unsigned char*)lds_raw;
    const int G = gridDim.x;
#define IN(k) (LO <= (k) && (k) < HI)
#define SEAM(k) do { if constexpr (COOP && IN(k) && IN((k) + 1)) { xcd_barrier(xbar); } } while (0)
    unsigned char* ws = P.ws; unsigned char* dob = (unsigned char*)P.out;
    XcdBarrier xbar; xbar.bar = (unsigned*)(ws + WS_CTL); xbar.x = 0; xbar.st = (volatile LAS unsigned*)(lds + LDS_BYTES - 256);
    if constexpr (COOP) {
        if (threadIdx.x < 2) xbar.st[threadIdx.x] = 0u;
        __syncthreads();
        xbar = xcd_barrier_post(xbar.bar, xbar.st);
        if (P.ws == nullptr) cg::this_grid().sync();
    }
    if constexpr (IN(0)) { p0_prologue(P, lds); __syncthreads(); SEAM(0); }
    if constexpr (IN(1)) {
        pg8::Gemm g{(const bf16_t*)(ws + WS_H), (const bf16_t*)(ws + WS_WIN), NTOK, NPROJ, DM};
        pg8::StaticOrder S; S.init(NTOK, NPROJ, G, (int)blockIdx.x);
        EpiInProj E{(bf16_t*)(dob + DO_Q), (bf16_t*)(dob + DO_K), (bf16_t*)(ws + WS_V), (bf16_t*)(ws + WS_GA), (bf16_t*)(dob + DO_Z), (bf16_t*)(ws + WS_GF), P.qg, P.kg};
        pg8::gemm_phase<EpiInProj, pg8::StaticOrder, true, true>(lds, g, S, E);
        SEAM(1);
    }
    if constexpr (IN(2)) { fft_stage1(P, lds); }
    if constexpr (IN(3)) { attn_chunks(P, lds, 0, (G == 256) ? 3 : (1536 + 2 * G - 1) / (2 * G)); SEAM(3); }
    if constexpr (IN(4)) { fft_stage2(P, lds); }
    if constexpr (IN(5)) { attn_chunks(P, lds, (G == 256) ? 3 : (1536 + 2 * G - 1) / (2 * G), (G == 256) ? 6 : (1536 + G - 1) / G); }
    if constexpr (IN(6)) { SEAM(6); }
    if constexpr (IN(7)) {
        pg8::Gemm g{(const bf16_t*)(ws + WS_H), (const bf16_t*)(ws + WS_WOUT), NTOK, DM, DM};
        pg8::StaticOrder S; S.init(NTOK, DM, G, (int)blockIdx.x, 1);
        EpiOut E{P.xp, P.xs, P.out, lds + EPI_STG};
        pg8::gemm_phase<EpiOut, pg8::StaticOrder, true, true>(lds, g, S, E);
    }
#undef IN
#undef SEAM
}

#ifndef MK_PROBE
#define MK_PROBE -1
#endif
extern "C" void kernel_launch(void* const* d_in, const int* in_sizes, int n_in, void* d_out, int out_size, void* d_ws, size_t ws_size, hipStream_t stream) {
    static int grid = 0;
    auto kfn = mk_fwd<0, NPHASE, true>;
    if (grid == 0) {
        if (n_in != 9 || in_sizes[0] != NPT * DM || in_sizes[1] != NPT * DM || out_size != NTOK * DM || ws_size < WS_END) {
            fprintf(stderr, "kernel_launch: unexpected shapes (n_in %d, out %d, ws %zu); nothing launched\n", n_in, out_size, ws_size); grid = -1; return; }
        int dev = 0, cus = 0, per_cu = 0;
        if (hipGetDevice(&dev) != hipSuccess || hipDeviceGetAttribute(&cus, hipDeviceAttributeMultiprocessorCount, dev) != hipSuccess) { grid = -1; return; }
        if (hipFuncSetAttribute((const void*)kfn, hipFuncAttributeMaxDynamicSharedMemorySize, LDS_BYTES) != hipSuccess) { fprintf(stderr, "kernel_launch: hipFuncSetAttribute failed\n"); grid = -1; return; }
        if (hipOccupancyMaxActiveBlocksPerMultiprocessor(&per_cu, (const void*)kfn, 512, LDS_BYTES) != hipSuccess || per_cu < 1) { fprintf(stderr, "kernel_launch: occupancy query failed (%d)\n", per_cu); grid = -1; return; }
        grid = cus * 1;
    }
    if (grid < 0) return;
    Params p{};
    p.xp = (const float*)d_in[0]; p.xs = (const float*)d_in[1]; p.norm_g = (const float*)d_in[2]; p.w_in = (const float*)d_in[3];
    p.qg = (const float*)d_in[4]; p.kg = (const float*)d_in[5]; p.rel_bias = (const float*)d_in[6]; p.w_four = (const float*)d_in[7]; p.w_out = (const float*)d_in[8];
    p.out = (float*)d_out; p.ws = (unsigned char*)d_ws;
#if MK_PROBE >= 0
#define LP(LO, HI) do { static bool at_ = false; auto k_ = mk_fwd<LO, HI, false>; if (!at_) { (void)hipFuncSetAttribute((const void*)k_, hipFuncAttributeMaxDynamicSharedMemorySize, LDS_BYTES); at_ = true; } \
        hipLaunchKernelGGL(k_, dim3(grid), dim3(512), LDS_BYTES, stream, p); } while (0)
    LP(0, 1); if (MK_PROBE == 0) LP(0, 1);
    LP(1, 2); if (MK_PROBE == 1) LP(1, 2);
    if (MK_PROBE == 5) LP(5, 6);
    if (MK_PROBE == 6) LP(6, 7);
    LP(2, 3);
    LP(3, 4); if (MK_PROBE == 3) LP(3, 4);
    LP(4, 5); if (MK_PROBE == 4) LP(4, 5);
    LP(5, 6); LP(6, 7);
    LP(7, 8); if (MK_PROBE == 7) LP(7, 8);
#else
    if (hipMemsetAsync((char*)d_ws + WS_CTL, 0, XCD_BAR_WORDS * 4, stream) != hipSuccess) { fprintf(stderr, "kernel_launch: hipMemsetAsync failed\n"); return; }
    void* args[] = {&p};
    const hipError_t e = hipLaunchCooperativeKernel((const void*)kfn, dim3(grid), dim3(512), args, LDS_BYTES, stream);
    if (e != hipSuccess) fprintf(stderr, "kernel_launch: cooperative launch failed: %s (grid %d)\n", hipGetErrorString(e), grid);
#endif
}
```

```cpp
#include <hip/hip_runtime.h>
#include <hip/hip_cooperative_groups.h>
#include <cstdio>
#include <cstdint>
namespace cg = cooperative_groups;

#define DI __device__ __forceinline__
#define LAS __attribute__((address_space(3)))
typedef unsigned short bf16_t;
typedef short bf16x8 __attribute__((ext_vector_type(8)));
typedef short s16x4 __attribute__((ext_vector_type(4)));
typedef float f32x4 __attribute__((ext_vector_type(4)));
typedef float f32x16 __attribute__((ext_vector_type(16)));
typedef unsigned u32x4 __attribute__((ext_vector_type(4)));
typedef unsigned u32x2 __attribute__((ext_vector_type(2)));
typedef float f32x2_t __attribute__((ext_vector_type(2)));
typedef __bf16 bf16x2_t __attribute__((ext_vector_type(2)));
typedef short v4i16_t __attribute__((ext_vector_type(4)));

DI unsigned pk2(float lo, float hi) { f32x2_t v = {lo, hi}; bf16x2_t b = __builtin_convertvector(v, bf16x2_t); return __builtin_bit_cast(unsigned, b); }
DI float bflo(unsigned u) { return __uint_as_float(u << 16); }
DI float bfhi(unsigned u) { return __uint_as_float(u & 0xffff0000u); }
DI float silu_f(float v) { return v * __frcp_rn(1.0f + __expf(-v)); }
DI float wave_sum(float v) {
#pragma unroll
    for (int o = 1; o < 64; o <<= 1) v += __shfl_xor(v, o);
    return v;
}
#define LDS_WAIT() asm volatile("s_waitcnt lgkmcnt(0)" ::: "memory")
DI int fresh_tid() { int t = threadIdx.x; asm volatile("" : "+v"(t)); return t; }

constexpr int NTOK = 65536, NPT = 32768, DM = 1024, DATT = 768, NPROJ = 3840, WIN_LD = 3584;
constexpr float RMS_EPS = 1e-6f;
constexpr float LOG2E = 1.4426950408889634f;
constexpr float C2 = 0.125f * LOG2E;

constexpr size_t MiB = 1u << 20;
constexpr size_t WS_CTL = 0;
constexpr size_t WS_WIN = 2 * MiB;
constexpr size_t WS_WOUT = 10 * MiB;
constexpr size_t WS_F1P = 12 * MiB;
constexpr size_t WS_F1S = WS_F1P + 131072;
constexpr size_t WS_F2 = WS_F1S + 32768;
constexpr size_t WS_TWP = WS_F2 + 16384;
constexpr size_t WS_TWS = WS_TWP + 65536;
constexpr size_t WS_TB = WS_TWS + 32768;
constexpr size_t WS_H = 16 * MiB;
constexpr size_t WS_V = 144 * MiB;
constexpr size_t WS_GA = 240 * MiB;
constexpr size_t WS_GF = 336 * MiB;
constexpr size_t WS_PO = 368 * MiB;
constexpr size_t WS_L = 464 * MiB;
constexpr size_t WS_END = 468 * MiB;
constexpr size_t DO_Q = 0, DO_K = 96 * MiB, DO_Z = 192 * MiB;

namespace pg8 {
#define PG8_LAS __attribute__((address_space(3)))
constexpr int BM = 256, BK = 64, HALF = 128, HTB = HALF * BK * 2, STAGE_BYTES = 8 * HTB, NXCD = 8, WGM = 8;
__host__ __device__ __forceinline__ int lds_byte(int r, int c) { const int st = (r >> 4) * 2 + (c >> 5), rr = r & 15, cc = c & 31, ob = rr * 64 + cc * 2; return st * 1024 + (ob ^ (((ob >> 9) & 1) << 5)); }
__host__ __device__ __forceinline__ void stage_rc(int b, int& R, int& C) { const int st = b / 1024, sb = b % 1024, swz = sb ^ (((sb >> 9) & 1) << 5); R = (st >> 1) * 16 + swz / 64; C = (st & 1) * 32 + (swz % 64) / 2; }
__host__ __device__ __forceinline__ int perm32(int rho) { const int n = rho >> 4, i = rho & 15; return 8 * (i >> 2) + 4 * n + (i & 3); }
struct Unit { int pm, pn; };
struct Gemm { const bf16_t* A; const bf16_t* Bt; int M, N, K; };
struct StaticOrder {
    int nM, nN, nwg, G, c, flip;
    __host__ __device__ void init(int M, int N, int G_, int c_, int flip_ = 0) { nM = M / BM; nN = N / BM; nwg = nM * nN; G = G_; c = c_; flip = flip_; }
    __host__ __device__ bool next(int i, Unit& u) const {
        const long L = (long)i * G + c; if (L >= nwg) return false;
        int wgid = (int)L; { const int q = nwg / NXCD, r = nwg % NXCD, xcd = wgid % NXCD, off = wgid / NXCD; wgid = (xcd < r ? xcd * (q + 1) : r * (q + 1) + (xcd - r) * q) + off; }
        const int nig = WGM * nN, gid = wgid / nig, fm = gid * WGM, gsz = (nM - fm) < WGM ? (nM - fm) : WGM;
        u.pm = fm + ((wgid % nig) % gsz); u.pn = (wgid % nig) / gsz; if (flip) u.pm = nM - 1 - u.pm; return true;
    }
    __device__ __forceinline__ void a_ready(const Unit&) const {}
    __device__ __forceinline__ void done(const Unit&) const {}
};
template <class Epi, class Sched, bool ALIGN_EPI = false, bool SP2 = false>
__device__ __forceinline__ void gemm_phase(PG8_LAS unsigned char* lds, const Gemm g, const Sched& S, const Epi& E) {
    const int tid = fresh_tid(), wid = __builtin_amdgcn_readfirstlane(tid >> 6), lane = tid & 63, wr = wid >> 2, wc = wid & 3, fr = lane & 15, fq = lane >> 4;
    const int K = g.K, nt = K / BK;
    unsigned voffA[2], voffB[2];
#pragma unroll
    for (int i = 0; i < 2; ++i) { int R, C; stage_rc(tid * 16 + i * 8192, R, C); const int Rb = Epi::PERM ? ((R & ~31) + perm32(R & 31)) : R;
        voffA[i] = (unsigned)(R * K + C) * 2u; voffB[i] = (unsigned)(Rb * K + C) * 2u; }
    const size_t kstep = (size_t)(BK * 2);
    const size_t hstep = (size_t)HALF * K * 2;
    const size_t tstep = 2 * hstep;
    const unsigned ldsw = (unsigned)wid * 1024u;
    const int aoff = lds_byte(wr * 64 + fr, fq * 8), boff = lds_byte(wc * 32 + fr, fq * 8);
#define PG8_SA(b, h) (((b) * 2 + (h)) * HTB)
#define PG8_SB(b, h) ((4 + (b) * 2 + (h)) * HTB)
#define PG8_STAGE(bufoff, gbase, voff) do { _Pragma("unroll") for (int _i = 0; _i < 2; ++_i) \
        __builtin_amdgcn_global_load_lds((const unsigned*)((const char*)(gbase) + (voff)[_i]), (PG8_LAS unsigned*)(lds + (bufoff) + ldsw + _i * 8192), 16, 0, 0); } while (0)
#define PG8_LDA(dst, b, h) do { _Pragma("unroll") for (int m = 0; m < 4; ++m) _Pragma("unroll") for (int k = 0; k < 2; ++k) dst[m][k] = *(const PG8_LAS bf16x8*)(lds + PG8_SA(b, h) + aoff + m * 2048 + k * 1024); } while (0)
#define PG8_LDB(dst, b, h) do { _Pragma("unroll") for (int n = 0; n < 2; ++n) _Pragma("unroll") for (int k = 0; k < 2; ++k) dst[n][k] = *(const PG8_LAS bf16x8*)(lds + PG8_SB(b, h) + boff + n * 2048 + k * 1024); } while (0)
#define PG8_MMA(ai, bj, At, Bt) do { __builtin_amdgcn_s_setprio(1); _Pragma("unroll") for (int m = 0; m < 4; ++m) _Pragma("unroll") for (int n = 0; n < 2; ++n) _Pragma("unroll") for (int k = 0; k < 2; ++k) \
        acc[ai][bj][m][n] = __builtin_amdgcn_mfma_f32_16x16x32_bf16(Bt[n][k], At[m][k], acc[ai][bj][m][n], 0, 0, 0); __builtin_amdgcn_s_setprio(0); } while (0)
#define PG8_WAIT_V(n) asm volatile("s_waitcnt vmcnt(" #n ")" ::: "memory")
#define PG8_WAIT_L(n) asm volatile("s_waitcnt lgkmcnt(" #n ")" ::: "memory")
#define PG8_BAR __builtin_amdgcn_s_barrier()
#define PG8_SCHED __builtin_amdgcn_sched_barrier(0)
    Unit cur, nxt; int ui = 0;
    if (!S.next(0, cur)) return;
    f32x4 acc[2][2][4][2];
#pragma unroll
    for (int a = 0; a < 2; ++a)
#pragma unroll
        for (int b = 0; b < 2; ++b)
#pragma unroll
            for (int m = 0; m < 4; ++m)
#pragma unroll
                for (int n = 0; n < 2; ++n) acc[a][b][m][n] = (f32x4){0.f, 0.f, 0.f, 0.f};
    bf16x8 At[4][2], B0[2][2], B1[2][2];
    const char* cA = (const char*)g.A + (size_t)cur.pm * tstep; const char* cB = (const char*)g.Bt + (size_t)cur.pn * tstep;
    S.a_ready(cur);
    if constexpr (SP2) {
        PG8_STAGE(PG8_SB(0, 0), cB, voffB); PG8_STAGE(PG8_SB(0, 1), cB + hstep, voffB); PG8_STAGE(PG8_SA(0, 0), cA, voffA); PG8_STAGE(PG8_SA(0, 1), cA + hstep, voffA);
        if (wr == 1) PG8_BAR;
        PG8_WAIT_V(2); PG8_BAR;
        PG8_STAGE(PG8_SB(1, 0), cB + kstep, voffB); PG8_STAGE(PG8_SA(1, 0), cA + kstep, voffA); PG8_STAGE(PG8_SB(1, 1), cB + hstep + kstep, voffB);
        PG8_WAIT_V(6); PG8_BAR;
    } else {
        PG8_STAGE(PG8_SB(0, 0), cB, voffB); PG8_STAGE(PG8_SA(0, 0), cA, voffA); PG8_STAGE(PG8_SB(0, 1), cB + hstep, voffB); PG8_STAGE(PG8_SA(0, 1), cA + hstep, voffA);
        if (wr == 1) PG8_BAR;
        PG8_WAIT_V(4); PG8_BAR;
        PG8_STAGE(PG8_SB(1, 0), cB + kstep, voffB); PG8_STAGE(PG8_SA(1, 0), cA + kstep, voffA); PG8_STAGE(PG8_SB(1, 1), cB + hstep + kstep, voffB);
        PG8_WAIT_V(6); PG8_BAR;
    }
    for (;;) {
        const bool has_next = S.next(ui + 1, nxt);
        const char* nA = has_next ? (const char*)g.A + (size_t)nxt.pm * tstep : cA; const char* nB = has_next ? (const char*)g.Bt + (size_t)nxt.pn * tstep : cB;
        for (int t = 0; t < nt; t += 2) {
            const bool last = (t == nt - 2);
            const char* a1 = cA + (size_t)(t + 1) * kstep;
            const char* a2 = last ? nA : cA + (size_t)(t + 2) * kstep; const char* b2 = last ? nB : cB + (size_t)(t + 2) * kstep;
            const char* a3 = a2 + kstep; const char* b3 = b2 + kstep;
            if (last && has_next) S.a_ready(nxt);
            if constexpr (SP2) {
            PG8_LDB(B0, 0, 0); PG8_LDB(B1, 0, 1); PG8_SCHED; PG8_LDA(At, 0, 0); PG8_STAGE(PG8_SA(1, 1), a1 + hstep, voffA);
            PG8_WAIT_V(8); PG8_WAIT_L(0); PG8_BAR; PG8_MMA(0, 0, At, B0); PG8_MMA(0, 1, At, B1); PG8_BAR; PG8_SCHED;
            PG8_LDA(At, 0, 1); PG8_STAGE(PG8_SB(0, 0), b2, voffB); PG8_STAGE(PG8_SB(0, 1), b2 + hstep, voffB); PG8_STAGE(PG8_SA(0, 0), a2, voffA);
            PG8_WAIT_V(8); PG8_WAIT_L(0); PG8_BAR; PG8_MMA(1, 0, At, B0); PG8_MMA(1, 1, At, B1); PG8_BAR; PG8_SCHED;
            PG8_LDB(B0, 1, 0); PG8_LDB(B1, 1, 1); PG8_SCHED; PG8_LDA(At, 1, 0); PG8_STAGE(PG8_SA(0, 1), a2 + hstep, voffA);
            PG8_WAIT_V(8); PG8_WAIT_L(0); PG8_BAR; PG8_MMA(0, 0, At, B0); PG8_MMA(0, 1, At, B1); PG8_BAR; PG8_SCHED;
            PG8_LDA(At, 1, 1); PG8_STAGE(PG8_SB(1, 0), b3, voffB); PG8_STAGE(PG8_SB(1, 1), b3 + hstep, voffB); PG8_STAGE(PG8_SA(1, 0), a3, voffA);
            PG8_WAIT_V(8); PG8_WAIT_L(0); PG8_BAR; PG8_MMA(1, 0, At, B0); PG8_MMA(1, 1, At, B1); PG8_BAR; PG8_SCHED;
            } else {
            PG8_LDB(B0, 0, 0); PG8_SCHED; PG8_LDA(At, 0, 0); PG8_STAGE(PG8_SA(1, 1), a1 + hstep, voffA);
            PG8_WAIT_L(8); PG8_BAR; PG8_WAIT_L(0); PG8_MMA(0, 0, At, B0); PG8_BAR; PG8_SCHED;
            PG8_LDB(B1, 0, 1); PG8_STAGE(PG8_SB(0, 0), b2, voffB);
            PG8_BAR; PG8_WAIT_L(0); PG8_MMA(0, 1, At, B1); PG8_BAR;
            PG8_LDA(At, 0, 1); PG8_STAGE(PG8_SA(0, 0), a2, voffA);
            PG8_BAR; PG8_WAIT_L(0); PG8_MMA(1, 0, At, B0); PG8_BAR; PG8_SCHED;
            PG8_STAGE(PG8_SB(0, 1), b2 + hstep, voffB);
            PG8_WAIT_V(6); PG8_BAR; PG8_MMA(1, 1, At, B1); PG8_BAR;
            PG8_LDB(B0, 1, 0); PG8_SCHED; PG8_LDA(At, 1, 0); PG8_STAGE(PG8_SA(0, 1), a2 + hstep, voffA);
            PG8_WAIT_L(8); PG8_BAR; PG8_WAIT_L(0); PG8_MMA(0, 0, At, B0); PG8_BAR; PG8_SCHED;
            PG8_LDB(B1, 1, 1); PG8_STAGE(PG8_SB(1, 0), b3, voffB);
            PG8_BAR; PG8_WAIT_L(0); PG8_MMA(0, 1, At, B1); PG8_BAR;
            PG8_LDA(At, 1, 1); PG8_STAGE(PG8_SA(1, 0), a3, voffA);
            PG8_BAR; PG8_WAIT_L(0); PG8_MMA(1, 0, At, B0); PG8_BAR; PG8_SCHED;
            PG8_STAGE(PG8_SB(1, 1), b3 + hstep, voffB);
            PG8_WAIT_V(6); PG8_BAR; PG8_MMA(1, 1, At, B1); PG8_BAR;
            }
        }
        if constexpr (ALIGN_EPI) { if (wr == 0) PG8_BAR; }
        E(acc, cur, wr, wc, fr, fq); S.done(cur);
        if (!has_next) break;
#pragma unroll
        for (int a = 0; a < 2; ++a)
#pragma unroll
            for (int b = 0; b < 2; ++b)
#pragma unroll
                for (int m = 0; m < 4; ++m)
#pragma unroll
                    for (int n = 0; n < 2; ++n) acc[a][b][m][n] = (f32x4){0.f, 0.f, 0.f, 0.f};
        cur = nxt; cA = nA; cB = nB; ++ui;
        if constexpr (ALIGN_EPI) { if (wr == 1) PG8_BAR; }
    }
    PG8_WAIT_V(0);
    if constexpr (!ALIGN_EPI) { if (wr == 0) PG8_BAR; }
    PG8_BAR;
#undef PG8_SA
#undef PG8_SB
#undef PG8_STAGE
#undef PG8_LDA
#undef PG8_LDB
#undef PG8_MMA
#undef PG8_WAIT_V
#undef PG8_WAIT_L
#undef PG8_BAR
#undef PG8_SCHED
}
}

struct EpiInProj {
    static constexpr bool PERM = true;
    bf16_t *Q, *K, *V, *GA, *Z, *GF; const float *qg, *kg;
    DI void store8(bf16_t* p, const f32x4& a, const f32x4& b) const {
        u32x4 w; w.x = pk2(a[0], a[1]); w.y = pk2(a[2], a[3]); w.z = pk2(b[0], b[1]); w.w = pk2(b[2], b[3]); *(u32x4*)p = w; }
    DI size_t hm_off(int pm, int head, int srow) const {
        int tokb, S, s0;
        if (pm < 128) { tokb = (pm >> 5) * 8192; S = 8192; s0 = (pm & 31) * 256; } else { const int q = pm - 128; tokb = NPT + (q >> 4) * 4096; S = 4096; s0 = (q & 15) * 256; }
        return ((size_t)tokb * 12 + (size_t)head * S + s0 + srow) * 64;
    }
    DI void operator()(const f32x4 (&acc)[2][2][4][2], const pg8::Unit& u, int wr, int wc, int fr, int fq) const {
        const int pn = u.pn; const int row0 = u.pm * 256 + wr * 64 + fr; const int srow0 = wr * 64 + fr;
        if (pn < 6) {
            const bool isq = pn < 3; const float* g = isq ? qg : kg; const float sc = isq ? C2 : 1.0f;
            bf16_t* O = isq ? Q : K; const int head = (isq ? pn : pn - 3) * 4 + wc;
            bf16_t* ob = O + hm_off(u.pm, head, srow0) + 8 * fq;
            f32x4 gv[2][2];
#pragma unroll
            for (int bj = 0; bj < 2; ++bj)
#pragma unroll
                for (int n = 0; n < 2; ++n) { gv[bj][n] = *(const f32x4*)(g + 32 * bj + 8 * fq + 4 * n); gv[bj][n] = gv[bj][n] * sc; }
#pragma unroll
            for (int ai = 0; ai < 2; ++ai)
#pragma unroll
                for (int m = 0; m < 4; ++m) {
                    float ss = 0.f;
#pragma unroll
                    for (int bj = 0; bj < 2; ++bj)
#pragma unroll
                        for (int n = 0; n < 2; ++n) { const f32x4 v = acc[ai][bj][m][n]; ss += (v[0] * v[0] + v[1] * v[1]) + (v[2] * v[2] + v[3] * v[3]); }
                    ss += __shfl_xor(ss, 16); ss += __shfl_xor(ss, 32);
                    const float rs = 1.0f / sqrtf(ss * (1.0f / 64.0f) + RMS_EPS);
                    bf16_t* rowp = ob + (size_t)(ai * 128 + m * 16) * 64;
#pragma unroll
                    for (int bj = 0; bj < 2; ++bj) store8(rowp + 32 * bj, acc[ai][bj][m][0] * rs * gv[bj][0], acc[ai][bj][m][1] * rs * gv[bj][1]);
                }
        } else if (pn < 9) {
            const int head = (pn - 6) * 4 + wc; bf16_t* ob = V + hm_off(u.pm, head, srow0) + 8 * fq;
#pragma unroll
            for (int ai = 0; ai < 2; ++ai)
#pragma unroll
                for (int m = 0; m < 4; ++m) { bf16_t* rowp = ob + (size_t)(ai * 128 + m * 16) * 64;
#pragma unroll
                    for (int bj = 0; bj < 2; ++bj) store8(rowp + 32 * bj, acc[ai][bj][m][0], acc[ai][bj][m][1]); }
        } else if (pn < 12) {
            const int head = (pn - 9) * 4 + wc; bf16_t* ob = GA + hm_off(u.pm, head, srow0) + 8 * fq;
#pragma unroll
            for (int ai = 0; ai < 2; ++ai)
#pragma unroll
                for (int m = 0; m < 4; ++m) { bf16_t* rowp = ob + (size_t)(ai * 128 + m * 16) * 64;
#pragma unroll
                    for (int bj = 0; bj < 2; ++bj) { f32x4 a = acc[ai][bj][m][0], b = acc[ai][bj][m][1];
#pragma unroll
                        for (int i = 0; i < 4; ++i) { a[i] = silu_f(a[i]); b[i] = silu_f(b[i]); }
                        store8(rowp + 32 * bj, a, b); } }
        } else if (pn < 14) {
            const int col = (pn - 12) * 256 + wc * 64 + 8 * fq;
#pragma unroll
            for (int ai = 0; ai < 2; ++ai)
#pragma unroll
                for (int m = 0; m < 4; ++m) { bf16_t* rowp = Z + (size_t)(row0 + ai * 128 + m * 16) * 512 + col;
#pragma unroll
                    for (int bj = 0; bj < 2; ++bj) store8(rowp + 32 * bj, acc[ai][bj][m][0], acc[ai][bj][m][1]); }
        } else {
            const int col = wc * 64 + 8 * fq;
#pragma unroll
            for (int ai = 0; ai < 2; ++ai)
#pragma unroll
                for (int m = 0; m < 4; ++m) { bf16_t* rowp = GF + (size_t)(row0 + ai * 128 + m * 16) * 256 + col;
#pragma unroll
                    for (int bj = 0; bj < 2; ++bj) { f32x4 a = acc[ai][bj][m][0], b = acc[ai][bj][m][1];
#pragma unroll
                        for (int i = 0; i < 4; ++i) { a[i] = silu_f(a[i]); b[i] = silu_f(b[i]); }
                        store8(rowp + 32 * bj, a, b); } }
        }
    }
};
struct EpiOut {
    static constexpr bool PERM = true;
    const float *xp, *xs; float* out; LAS unsigned char* stgbase;
    DI void operator()(const f32x4 (&acc)[2][2][4][2], const pg8::Unit& u, int wr, int wc, int fr, int fq) const {
        LAS unsigned char* stg = stgbase + (wr * 4 + wc) * 4096;
        const int lane = fq * 16 + fr, rr = lane >> 3, cc = lane & 7;
        const int rowb = u.pm * 256 + wr * 64, colb = u.pn * 256 + wc * 32;
        const float* xb = (u.pm < 128) ? xp + (size_t)rowb * DM : xs + (size_t)(rowb - NPT) * DM;
        float* ob = out + (size_t)rowb * DM;
#define EPO_XA(g, h) ((const f32x4*)(xb + (size_t)(((g) >> 3) * 128 + (((g) >> 1) & 3) * 16 + rr + 8 * (h)) * DM + colb + ((g) & 1) * 128 + 4 * cc))
        constexpr int EPO_D = 6;
        f32x4 xv[16][2];
#pragma unroll
        for (int g = 0; g < EPO_D; ++g)
#pragma unroll
            for (int h = 0; h < 2; ++h) xv[g][h] = __builtin_nontemporal_load(EPO_XA(g, h));
#pragma unroll
        for (int g = 0; g < 16; ++g) {
            const int ai = g >> 3, m = (g >> 1) & 3, bj = g & 1;
            *(LAS f32x4*)(stg + fr * 144 + (8 * fq) * 4) = acc[ai][bj][m][0];
            *(LAS f32x4*)(stg + fr * 144 + (8 * fq + 4) * 4) = acc[ai][bj][m][1];
#pragma unroll
            for (int h = 0; h < 2; ++h) {
                const f32x4 y = *(const LAS f32x4*)(stg + (rr + 8 * h) * 144 + cc * 16);
                __builtin_nontemporal_store(xv[g][h] + y, (f32x4*)(ob + (size_t)(ai * 128 + m * 16 + rr + 8 * h) * DM + colb + bj * 128 + 4 * cc));
            }
            if (g + EPO_D < 16) {
#pragma unroll
                for (int h = 0; h < 2; ++h) xv[g + EPO_D][h] = __builtin_nontemporal_load(EPO_XA(g + EPO_D, h));
            }
        }
#undef EPO_XA
    }
};

struct Params {
    const float *xp, *xs, *norm_g, *w_in, *qg, *kg, *rel_bias, *w_four, *w_out;
    float* out; unsigned char* ws;
};

DI void p0_transpose_item(const float* W, int ldw, int col0, const float* gain, bf16_t* WTrow0, int K, int k0, LAS float* scr, int lane) {
    float tv[32];
#pragma unroll
    for (int i = 0; i < 32; ++i) { const int kk = 2 * i + (lane >> 5); tv[i] = W[(size_t)(k0 + kk) * ldw + col0 + (lane & 31)]; }
#pragma unroll
    for (int i = 0; i < 32; ++i) { const int kk = 2 * i + (lane >> 5); float v = tv[i]; if (gain) v *= gain[k0 + kk]; scr[kk * 33 + (lane & 31)] = v; }
    LDS_WAIT();
    const int c = lane & 7;
#pragma unroll
    for (int j = 0; j < 4; ++j) { const int n = (lane >> 3) + 8 * j; const LAS float* s = scr + (8 * c) * 33 + n;
        u32x4 o; o.x = pk2(s[0 * 33], s[1 * 33]); o.y = pk2(s[2 * 33], s[3 * 33]); o.z = pk2(s[4 * 33], s[5 * 33]); o.w = pk2(s[6 * 33], s[7 * 33]);
        *(u32x4*)(WTrow0 + (size_t)n * K + k0 + 8 * c) = o; }
    LDS_WAIT();
}
DI int t5_bucket(int rel) {
    const int n = rel < 0 ? -rel : rel; int b = rel > 0 ? 16 : 0;
    if (n < 8) return b + n;
    int large = 8 + (int)((logf((float)n / 8.0f) / 4.852030263919617f) * 8.0f);
    if (large > 15) large = 15;
    return b + large;
}
DI void p0_prologue(const Params& P, LAS unsigned char* lds) {
    const int tid = fresh_tid(), lane = tid & 63, wave = __builtin_amdgcn_readfirstlane(tid >> 6);
    const int G = gridDim.x, bx = blockIdx.x;
    unsigned char* ws = P.ws;
    bf16_t* WIN = (bf16_t*)(ws + WS_WIN); bf16_t* WOUT = (bf16_t*)(ws + WS_WOUT);
    for (int bt = bx; bt < 267; bt += G) {
        if (bt < 256) {
            const int g = bt >> 6, part = (bt >> 5) & 1, kc = (bt >> 2) & 7, eq = bt & 3;
            LAS float* Mg = (LAS float*)lds;
            LAS float* tab = (LAS float*)(lds + 4096);
            LAS float* wf = (LAS float*)(lds + 4352);
            LAS float* wi = (LAS float*)(lds + 8448);
            if (tid < 64) { float s, c; sincospif((float)tid * (2.0f / 64.0f), &s, &c); tab[tid] = part ? -s : c; }
            if (tid < 256) { const int m = tid >> 2, e4 = tid & 3; *(LAS f32x4*)(wf + m * 16 + 4 * e4) = *(const f32x4*)(P.w_four + (size_t)g * 4096 + m * 64 + 16 * eq + 4 * e4); }
#pragma unroll
            for (int i = 0; i < 4; ++i) { const int q = tid + 512 * i, kr_ = q >> 4, c4 = q & 15; const f32x4 v = *(const f32x4*)(P.w_in + (size_t)(128 * kc + kr_) * WIN_LD + 3072 + 64 * g + 4 * c4);
                LAS float* d = wi + kr_ * 65 + 4 * c4; d[0] = v[0]; d[1] = v[1]; d[2] = v[2]; d[3] = v[3]; }
            __syncthreads();
#pragma unroll
            for (int i = 0; i < 2; ++i) { const int idx = tid + 512 * i, c = idx >> 4, el = idx & 15; float a = 0.f;
#pragma unroll 8
                for (int m = 0; m < 64; ++m) a += tab[(c * m) & 63] * wf[m * 16 + el];
                Mg[c * 16 + el] = a * 0.125f; }
            __syncthreads();
            const int el = tid & 15, kq = tid >> 4, e = 16 * eq + el;
            const int prow = (12 + part) * 256 + 128 * (e >> 5) + 32 * g + (e & 31);
            float r4[4];
#pragma unroll
            for (int i = 0; i < 4; ++i) { const int kl = 4 * kq + i; const LAS float* wr_ = wi + kl * 65; float a = 0.f;
#pragma unroll 8
                for (int c = 0; c < 64; ++c) a += wr_[c] * Mg[c * 16 + el];
                r4[i] = a * P.norm_g[128 * kc + kl]; }
            *(u32x2*)(WIN + (size_t)prow * DM + 128 * kc + 4 * kq) = (u32x2){pk2(r4[0], r4[1]), pk2(r4[2], r4[3])};
            __syncthreads();
        } else if (bt < 264) {
            bf16_t* F = (bf16_t*)(ws + WS_F1P); const float sc = 0.011048543456039806f;
            for (int idx = (bt - 256) * 8192 + tid; idx < (bt - 255) * 8192; idx += 512) { const int m = idx >> 8, k = idx & 255, k1 = m >> 1, po = m & 1, s1 = k >> 1, pi = k & 1;
                float s, c; sincospif((float)((k1 * s1) & 127) * (2.0f / 128.0f), &s, &c);
                const float v = (po == pi) ? c : (po ? -s : s);
                F[idx] = (bf16_t)(pk2(v * sc, 0.f) & 0xffffu); }
        } else if (bt == 264) {
            bf16_t* F = (bf16_t*)(ws + WS_F1S); const float sc = 0.015625f;
            for (int idx = tid; idx < 16384; idx += 512) { const int m = idx >> 7, k = idx & 127, k1 = m >> 1, po = m & 1, s1 = k >> 1, pi = k & 1;
                float s, c; sincospif((float)((k1 * s1) & 63) * (2.0f / 64.0f), &s, &c);
                const float v = (po == pi) ? c : (po ? -s : s);
                F[idx] = (bf16_t)(pk2(v * sc, 0.f) & 0xffffu); }
        } else if (bt == 265) {
            bf16_t* F = (bf16_t*)(ws + WS_F2);
            for (int idx = tid; idx < 8192; idx += 512) { const int k2 = idx >> 7, k = idx & 127, s2 = k >> 1, pi = k & 1;
                float s, c; sincospif((float)((k2 * s2) & 63) * (2.0f / 64.0f), &s, &c);
                F[idx] = (bf16_t)(pk2(pi ? s : c, 0.f) & 0xffffu); }
            float2* TP = (float2*)(ws + WS_TWP); float2* TS = (float2*)(ws + WS_TWS);
            for (int n = tid; n < 8192; n += 512) { float s, c; sincospif((float)n * (2.0f / 8192.0f), &s, &c); TP[n] = make_float2(c, s); }
            for (int n = tid; n < 4096; n += 512) { float s, c; sincospif((float)n * (2.0f / 4096.0f), &s, &c); TS[n] = make_float2(c, s); }
        } else {
            float mq = 0.f, mk = 0.f, mb = 0.f;
            for (int i = 0; i < 64; ++i) { mq = fmaxf(mq, fabsf(P.qg[i])); mk = fmaxf(mk, fabsf(P.kg[i])); }
            for (int i = 0; i < 384; ++i) mb = fmaxf(mb, fabsf(P.rel_bias[i]));
            const float off2 = (8.0f * mq * mk + mb) * LOG2E;
            float* TB = (float*)(ws + WS_TB);
            for (int idx = tid; idx < 3 * 12 * 192; idx += 512) { const int p = idx / (12 * 192), h = (idx / 192) % 12, ri = idx % 192, rel = ri - 96;
                const int dil = (p == 0) ? 1 : (p == 1 ? 4 : 16);
                float v = -1e30f;
                if (rel >= -64 && rel <= 64) v = P.rel_bias[t5_bucket(rel * dil) * 12 + h] * LOG2E - off2;
                TB[idx] = v; }
        }
    }
    __syncthreads();
    const int vcu = (G % 8 == 0) ? (bx % 8) * (G / 8) + bx / 8 : bx;
    const int gw = vcu * 8 + wave, NGW = G * 8;
    LAS float* scr = (LAS float*)(lds + wave * 16384);
    constexpr int I_IN = 13 * 8 * 16, I_OUT = 32 * 16;
    for (int it = gw; it < I_IN + I_OUT; it += NGW) {
        if (it < I_IN) { const int kb = it & 15, nb8 = (it >> 4) & 7, ti = it >> 7;
            const int pn = ti < 12 ? ti : 14; const int bj = nb8 >> 2, wc = nb8 & 3; const int lt0 = 64 * wc + 32 * bj;
            const int col0 = (pn < 12 ? 256 * pn : 3328) + lt0;
            p0_transpose_item(P.w_in, WIN_LD, col0, P.norm_g, WIN + (size_t)(pn * 256 + nb8 * 32) * DM, DM, kb * 64, scr, lane);
        } else { const int r = it - I_IN; const int kb = r & 15, nb = r >> 4;
            p0_transpose_item(P.w_out, DM, nb * 32, nullptr, WOUT + (size_t)(nb * 32) * DM, DM, kb * 64, scr, lane); }
    }
    bf16_t* H = (bf16_t*)(ws + WS_H);
    for (int m = gw; m < NTOK; m += 2 * NGW) {
        const int m2 = m + NGW;
        const bool has2 = m2 < NTOK;
        const float* xr0 = (m < NPT) ? P.xp + (size_t)m * DM : P.xs + (size_t)(m - NPT) * DM;
        const int m2c = has2 ? m2 : m;
        const float* xr1 = (m2c < NPT) ? P.xp + (size_t)m2c * DM : P.xs + (size_t)(m2c - NPT) * DM;
        const f32x4* x40 = (const f32x4*)xr0 + lane; const f32x4* x41 = (const f32x4*)xr1 + lane; f32x4 v0[4], v1[4]; float s0 = 0.f, s1 = 0.f;
#pragma unroll
        for (int j = 0; j < 4; ++j) { v0[j] = __builtin_nontemporal_load(x40 + 64 * j); v1[j] = __builtin_nontemporal_load(x41 + 64 * j); }
#pragma unroll
        for (int j = 0; j < 4; ++j) { s0 += (v0[j][0] * v0[j][0] + v0[j][1] * v0[j][1]) + (v0[j][2] * v0[j][2] + v0[j][3] * v0[j][3]);
                                      s1 += (v1[j][0] * v1[j][0] + v1[j][1] * v1[j][1]) + (v1[j][2] * v1[j][2] + v1[j][3] * v1[j][3]); }
        const float rs0 = 1.0f / sqrtf(wave_sum(s0) * (1.0f / 1024.0f) + RMS_EPS), rs1 = 1.0f / sqrtf(wave_sum(s1) * (1.0f / 1024.0f) + RMS_EPS);
        u32x2* o80 = (u32x2*)(H + (size_t)m * DM) + lane; u32x2* o81 = (u32x2*)(H + (size_t)m2c * DM) + lane;
#pragma unroll
        for (int j = 0; j < 4; ++j) __builtin_nontemporal_store((u32x2){pk2(v0[j][0] * rs0, v0[j][1] * rs0), pk2(v0[j][2] * rs0, v0[j][3] * rs0)}, o80 + 64 * j);
        if (has2) {
#pragma unroll
            for (int j = 0; j < 4; ++j) __builtin_nontemporal_store((u32x2){pk2(v1[j][0] * rs1, v1[j][1] * rs1), pk2(v1[j][2] * rs1, v1[j][3] * rs1)}, o81 + 64 * j);
        }
    }
}

DI int crow(int r, int hi) { return (r & 3) + 8 * (r >> 2) + 4 * hi; }
DI s16x4 vtr(LAS const unsigned char* p) { return __builtin_bit_cast(s16x4, __builtin_amdgcn_ds_read_tr16_b64_v4i16((LAS v4i16_t*)p)); }
constexpr int AY_O = 0, AY_L = 65536, AY_TB = 67584, AY_TBC = 784  , AY_TBP = 4 * 784  , AY_STG = 76992, AY_STGW = 4096;
struct ASeq { size_t base; int dil, L; };
DI void ay_load_tile(const bf16_t* K, const bf16_t* V, const ASeq& s, int mstart, int lane, bf16x8 (&kr)[4], u32x4 (&vr)[4]) {
    const int r32 = lane & 31, hi = lane >> 5;
    int mk = mstart + r32; mk = mk < 0 ? 0 : (mk >= s.L ? s.L - 1 : mk);
    const bf16_t* kp = K + s.base + (size_t)(mk * s.dil) * 64 + 8 * hi;
#pragma unroll
    for (int sd = 0; sd < 4; ++sd) kr[sd] = *(const bf16x8*)(kp + 16 * sd);
    if (mstart >= 0 && mstart + 32 <= s.L) {
        const bf16_t* vp = V + s.base + (size_t)((mstart + (lane >> 3)) * s.dil) * 64 + (lane & 7) * 8; const size_t st = (size_t)(8 * s.dil) * 64;
#pragma unroll
        for (int i = 0; i < 4; ++i) vr[i] = *(const u32x4*)(vp + i * st);
    } else {
#pragma unroll
        for (int i = 0; i < 4; ++i) { int m = mstart + (lane >> 3) + 8 * i; m = m < 0 ? 0 : (m >= s.L ? s.L - 1 : m);
            vr[i] = *(const u32x4*)(V + s.base + (size_t)(m * s.dil) * 64 + (lane & 7) * 8); }
    }
}
DI void ay_store_tile(LAS unsigned char* stg, int lane, const u32x4 (&vr)[4]) {
#pragma unroll
    for (int i = 0; i < 4; ++i) { const int row = (lane >> 3) + 8 * i, ch = lane & 7;
        *(LAS u32x4*)(stg + row * 128 + ((ch ^ (((row >> 1) & 1) << 2)) << 4)) = vr[i]; }
}
DI void ay_load_q(const bf16_t* Q, const ASeq& s, int m, int hi, bf16x8 (&q)[4]) {
    const size_t off = s.base + (size_t)(m * s.dil) * 64 + 8 * hi;
#pragma unroll
    for (int sd = 0; sd < 4; ++sd) q[sd] = *(const bf16x8*)(Q + off + 16 * sd);
}
DI void ay_tile(LAS const unsigned char* stg, LAS const unsigned char* TBP, int ktl, bool valid, const bf16x8 (&kf)[4], const bf16x8 (&qr)[4], f32x16& o0, f32x16& o1, float& lsum, int lane) {
    const int r32 = lane & 31, hi = lane >> 5, q4 = (lane & 15) >> 2, g1 = (lane >> 4) & 1, p3 = lane & 3;
    f32x16 s;
    if (valid) {
        const LAS unsigned char* tp = TBP + (r32 & 3) * AY_TBC + (32 * ktl + 4 * hi + 32 - (r32 & ~3)) * 4;
#pragma unroll
        for (int g = 0; g < 4; ++g) { const f32x4 t = *(const LAS f32x4*)(tp + 32 * g); s[4 * g] = t[0]; s[4 * g + 1] = t[1]; s[4 * g + 2] = t[2]; s[4 * g + 3] = t[3]; }
    } else {
#pragma unroll
        for (int i = 0; i < 16; ++i) s[i] = -1e30f;
    }
#pragma unroll
    for (int sd = 0; sd < 4; ++sd) s = __builtin_amdgcn_mfma_f32_32x32x16_bf16(kf[sd], qr[sd], s, 0, 0, 0);
    float ps = 0.f;
#pragma unroll
    for (int i = 0; i < 16; ++i) { s[i] = __builtin_amdgcn_exp2f(s[i]); ps += s[i]; }
    lsum += ps;
    bf16x8 pb[2];
#pragma unroll
    for (int sk = 0; sk < 2; ++sk) { u32x4 t; t.x = pk2(s[8 * sk], s[8 * sk + 1]); t.y = pk2(s[8 * sk + 2], s[8 * sk + 3]); t.z = pk2(s[8 * sk + 4], s[8 * sk + 5]); t.w = pk2(s[8 * sk + 6], s[8 * sk + 7]); pb[sk] = __builtin_bit_cast(bf16x8, t); }
#pragma unroll
    for (int sk = 0; sk < 2; ++sk) {
        const int vrow = 16 * sk + 4 * hi + q4; const int vsw = ((vrow >> 1) & 1) << 2;
#pragma unroll
        for (int dt = 0; dt < 2; ++dt) {
            const int chunk = (4 * dt + 2 * g1 + (p3 >> 1)) ^ vsw;
            const LAS unsigned char* vp = stg + vrow * 128 + (chunk << 4) + 8 * (p3 & 1);
            const s16x4 lo = vtr(vp), hi4 = vtr(vp + 8 * 128);
            const bf16x8 vf = (bf16x8){lo[0], lo[1], lo[2], lo[3], hi4[0], hi4[1], hi4[2], hi4[3]};
            if (dt == 0) o0 = __builtin_amdgcn_mfma_f32_32x32x16_bf16(vf, pb[sk], o0, 0, 0, 0);
            else o1 = __builtin_amdgcn_mfma_f32_32x32x16_bf16(vf, pb[sk], o1, 0, 0, 0);
        }
    }
}
template <bool ACCUM>
DI void ay_accum(LAS unsigned char* lds, const f32x16& o0, const f32x16& o1, float lsum, int rowbase, int rowstride, int lane) {
    const int r32 = lane & 31, hi = lane >> 5; int row = rowbase + r32 * rowstride;
    asm volatile("" : "+v"(row));
    const int hs = ((row >> 1) ^ (row >> 5)) & 15;
    LAS unsigned char* rp = lds + AY_O + row * 128;
    lsum += __shfl_xor(lsum, 32);
#pragma unroll
    for (int dt = 0; dt < 2; ++dt)
#pragma unroll
        for (int g = 0; g < 4; ++g) {
            const int c8 = 8 * dt + 2 * g + hi; LAS u32x2* p = (LAS u32x2*)(rp + ((c8 ^ hs) << 3));
            float v0 = dt ? o1[4 * g] : o0[4 * g], v1 = dt ? o1[4 * g + 1] : o0[4 * g + 1], v2 = dt ? o1[4 * g + 2] : o0[4 * g + 2], v3 = dt ? o1[4 * g + 3] : o0[4 * g + 3];
            if (ACCUM) { const u32x2 old = *p; v0 += bflo(old.x); v1 += bfhi(old.x); v2 += bflo(old.y); v3 += bfhi(old.y); }
            *p = (u32x2){pk2(v0, v1), pk2(v2, v3)};
        }
    if (hi == 0) { LAS float* lp = (LAS float*)(lds + AY_L) + row; *lp = ACCUM ? (*lp + lsum) : lsum; }
}
struct AChunk { int valid, h, S, tokb, c0; size_t base; };
DI AChunk ay_get_chunk(int i) {
    const int G = gridDim.x, bx = blockIdx.x; AChunk a; a.valid = 0; a.h = 0; a.S = 4096; a.tokb = 0; a.c0 = 0; a.base = 0;
    int id;
    if (G == 256) { if (i >= 6) return a; const int vcu = (bx & 7) * 32 + (bx >> 3), x = vcu >> 5, c = vcu & 31;
        id = (i < 3) ? ((6 * x + 2 * i + (c >> 4)) * 16 + (c & 15)) : (768 + (12 * x + 4 * (i - 3) + (c >> 3)) * 8 + (c & 7)); }
    else id = i * G + bx;
    if (id >= 1536) return a;
    int b, h, ck, S, tokb;
    if (id < 768) { const int pair = id >> 4; ck = id & 15; b = pair / 12; h = pair % 12; S = 8192; tokb = b * 8192; }
    else { const int id2 = id - 768; const int pair = id2 >> 3; ck = id2 & 7; b = pair / 12; h = pair % 12; S = 4096; tokb = NPT + b * 4096; }
    a.valid = 1; a.h = h; a.S = S; a.tokb = tokb; a.c0 = ck * 512; a.base = ((size_t)tokb * 12 + (size_t)h * S) * 64;
    return a;
}
DI void attn_chunks(const Params& P, LAS unsigned char* lds, int i_lo, int i_hi) {
    unsigned char* ws = P.ws; unsigned char* dob = (unsigned char*)P.out;
    const bf16_t* Q = (const bf16_t*)(dob + DO_Q); const bf16_t* K = (const bf16_t*)(dob + DO_K);
    const bf16_t* V = (const bf16_t*)(ws + WS_V); const bf16_t* GA = (const bf16_t*)(ws + WS_GA);
    bf16_t* MIX = (bf16_t*)(ws + WS_H); const float* TB = (const float*)(ws + WS_TB);
    const int tid = fresh_tid(), lane = tid & 63, w = __builtin_amdgcn_readfirstlane(tid >> 6), r32 = lane & 31, hi = lane >> 5;
    LAS unsigned char* stg = lds + AY_STG + w * AY_STGW;
    bf16x8 kr[4]; u32x4 vr[4];
    for (int ci = i_lo; ci < i_hi; ++ci) {
        const AChunk ck = ay_get_chunk(ci);
        if (!ck.valid) break;
        const int S = ck.S;
        const ASeq s1{ck.base, 1, S};                         const int m1 = ck.c0 + 64 * w;
        const ASeq s2{ck.base + (size_t)(w >> 1) * 64, 4, S / 4};  const int m2 = ck.c0 / 4 + 64 * (w & 1);
        const ASeq s3a{ck.base + (size_t)(2 * w) * 64, 16, S / 16}, s3b{ck.base + (size_t)(2 * w + 1) * 64, 16, S / 16}; const int m3 = ck.c0 / 16;
        __syncthreads();
        for (int t = tid; t < 3 * 4 * 196; t += 512) { const int p = t / 784, a = (t / 196) & 3, x = t % 196; const int j = x - a;
            ((LAS float*)(lds + AY_TB))[t] = (j >= 0 && j < 192) ? TB[p * (12 * 192) + ck.h * 192 + j] : 0.f; }
        ay_load_tile(K, V, s1, m1 - 64, lane, kr, vr);
        bf16x8 qa[4], qb[4], kf[4];
        ay_load_q(Q, s1, m1 + r32, hi, qa); ay_load_q(Q, s1, m1 + 32 + r32, hi, qb);
        __syncthreads();
#define AY_TAKE() do { ay_store_tile(stg, lane, vr); _Pragma("unroll") for (int sd_ = 0; sd_ < 4; ++sd_) kf[sd_] = kr[sd_]; } while (0)
        {
            f32x16 oa0, oa1, ob0, ob1; float la = 0.f, lb = 0.f;
#pragma unroll
            for (int i = 0; i < 16; ++i) { oa0[i] = 0.f; oa1[i] = 0.f; ob0[i] = 0.f; ob1[i] = 0.f; }
#pragma unroll 1
            for (int kt = 0; kt < 6; ++kt) {
                AY_TAKE();
                if (kt < 5) ay_load_tile(K, V, s1, m1 - 64 + 32 * (kt + 1), lane, kr, vr); else ay_load_tile(K, V, s2, m2 - 64, lane, kr, vr);
                const int ms = m1 - 64 + 32 * kt; const bool valid = (ms >= 0 && ms < s1.L);
                if (kt < 5) ay_tile(stg, lds + AY_TB, kt, valid, kf, qa, oa0, oa1, la, lane);
                __builtin_amdgcn_sched_barrier(0);
                if (kt > 0) ay_tile(stg, lds + AY_TB, kt - 1, valid, kf, qb, ob0, ob1, lb, lane);
                __builtin_amdgcn_sched_barrier(0);
            }
            ay_accum<false>(lds, oa0, oa1, la, 64 * w, 1, lane);
            ay_accum<false>(lds, ob0, ob1, lb, 64 * w + 32, 1, lane);
        }
        ay_load_q(Q, s2, m2 + r32, hi, qa); ay_load_q(Q, s2, m2 + 32 + r32, hi, qb);
        __syncthreads();
        {
            f32x16 oa0, oa1, ob0, ob1; float la = 0.f, lb = 0.f;
#pragma unroll
            for (int i = 0; i < 16; ++i) { oa0[i] = 0.f; oa1[i] = 0.f; ob0[i] = 0.f; ob1[i] = 0.f; }
#pragma unroll 1
            for (int kt = 0; kt < 6; ++kt) {
                AY_TAKE();
                if (kt < 5) ay_load_tile(K, V, s2, m2 - 64 + 32 * (kt + 1), lane, kr, vr); else ay_load_tile(K, V, s3a, m3 - 64, lane, kr, vr);
                const int ms = m2 - 64 + 32 * kt; const bool valid = (ms >= 0 && ms < s2.L);
                if (kt < 5) ay_tile(stg, lds + AY_TB + AY_TBP, kt, valid, kf, qa, oa0, oa1, la, lane);
                __builtin_amdgcn_sched_barrier(0);
                if (kt > 0) ay_tile(stg, lds + AY_TB + AY_TBP, kt - 1, valid, kf, qb, ob0, ob1, lb, lane);
                __builtin_amdgcn_sched_barrier(0);
            }
            ay_accum<true>(lds, oa0, oa1, la, 4 * (64 * (w & 1)) + (w >> 1), 4, lane);
            ay_accum<true>(lds, ob0, ob1, lb, 4 * (64 * (w & 1) + 32) + (w >> 1), 4, lane);
        }
        ay_load_q(Q, s3a, m3 + r32, hi, qa); ay_load_q(Q, s3b, m3 + r32, hi, qb);
        __syncthreads();
        {
            f32x16 oa0, oa1; float la = 0.f;
#pragma unroll
            for (int i = 0; i < 16; ++i) { oa0[i] = 0.f; oa1[i] = 0.f; }
#pragma unroll 1
            for (int kt = 0; kt < 5; ++kt) {
                AY_TAKE();
                if (kt < 4) ay_load_tile(K, V, s3a, m3 - 64 + 32 * (kt + 1), lane, kr, vr); else ay_load_tile(K, V, s3b, m3 - 64, lane, kr, vr);
                const int ms = m3 - 64 + 32 * kt; const bool valid = (ms >= 0 && ms < s3a.L);
                ay_tile(stg, lds + AY_TB + 2 * AY_TBP, kt, valid, kf, qa, oa0, oa1, la, lane);
            }
            ay_accum<true>(lds, oa0, oa1, la, 2 * w, 16, lane);
        }
        {
            f32x16 oa0, oa1; float la = 0.f;
#pragma unroll
            for (int i = 0; i < 16; ++i) { oa0[i] = 0.f; oa1[i] = 0.f; }
#pragma unroll 1
            for (int kt = 0; kt < 5; ++kt) {
                AY_TAKE();
                if (kt < 4) ay_load_tile(K, V, s3b, m3 - 64 + 32 * (kt + 1), lane, kr, vr);
                const int ms = m3 - 64 + 32 * kt; const bool valid = (ms >= 0 && ms < s3b.L);
                ay_tile(stg, lds + AY_TB + 2 * AY_TBP, kt, valid, kf, qb, oa0, oa1, la, lane);
            }
            ay_accum<true>(lds, oa0, oa1, la, 2 * w + 1, 16, lane);
        }
#undef AY_TAKE
        __syncthreads();
        {
#pragma unroll 1
            for (int hb = 0; hb < 2; ++hb) {
            u32x4 gav[4];
#pragma unroll
            for (int i = 0; i < 4; ++i) { const int item = tid + 512 * (4 * hb + i), row = item >> 3, ch = item & 7; gav[i] = *(const u32x4*)(GA + ck.base + (size_t)(ck.c0 + row) * 64 + ch * 8); }
#pragma unroll
            for (int i = 0; i < 4; ++i) { const int item = tid + 512 * (4 * hb + i), ch = item & 7; int row = item >> 3; asm volatile("" : "+v"(row)); const int hs = ((row >> 1) ^ (row >> 5)) & 15;
                const u32x2 pa = *(const LAS u32x2*)(lds + AY_O + row * 128 + (((2 * ch) ^ hs) << 3)), pb = *(const LAS u32x2*)(lds + AY_O + row * 128 + (((2 * ch + 1) ^ hs) << 3));
                const float il = 1.0f / ((const LAS float*)(lds + AY_L))[row]; const u32x4 gg = gav[i];
                u32x4 o; o.x = pk2(bflo(pa.x) * il * bflo(gg.x), bfhi(pa.x) * il * bfhi(gg.x)); o.y = pk2(bflo(pa.y) * il * bflo(gg.y), bfhi(pa.y) * il * bfhi(gg.y));
                o.z = pk2(bflo(pb.x) * il * bflo(gg.z), bfhi(pb.x) * il * bfhi(gg.z)); o.w = pk2(bflo(pb.y) * il * bflo(gg.w), bfhi(pb.y) * il * bfhi(gg.w));
                *(u32x4*)(MIX + (size_t)(ck.tokb + ck.c0 + row) * DM + ck.h * 64 + ch * 8) = o; }
            }
        }
    }
    __syncthreads();
}

constexpr int FF_DATA = 0, FF_STG = 65536, FF_STGW = 9216;
struct FSrc { const bf16_t* p; int row_stride, part_off, cpr_shift; };
DI void fft_fetch(const FSrc& s, int tid, u32x4 (&t)[8]) {
#pragma unroll
    for (int i = 0; i < 8; ++i) { const int c = tid + 512 * i, row = c >> s.cpr_shift, cc = c & ((1 << s.cpr_shift) - 1);
        t[i] = *(const u32x4*)(s.p + (size_t)(row >> 1) * s.row_stride + (row & 1) * s.part_off + cc * 8); }
}
template <int K>
DI void fft_commit(LAS unsigned char* lds, int cpr_shift, int tid, const u32x4 (&t)[8]) {
#pragma unroll
    for (int i = 0; i < 8; ++i) { const int c = tid + 512 * i, row = c >> cpr_shift, cc = c & ((1 << cpr_shift) - 1), img = cc >> 4, ch = cc & 15;
        *(LAS u32x4*)(lds + FF_DATA + img * (K * 256) + row * 256 + ((ch ^ (((row & 3) << 2) | ((row >> 2) & 3))) << 4)) = t[i]; }
}
constexpr int FF_TAB = 139264;
template <int M, int K, int N, int MODE>
DI void fft_compute(LAS unsigned char* lds, int tabofs  , bf16_t* Out, const float2* TW, const bf16_t* GF,
                    int tokbase, int aux  , int N1, int colbase) {
    constexpr int NTW = N / 128;
    const int tid = fresh_tid(), lane = tid & 63, w = __builtin_amdgcn_readfirstlane(tid >> 6);
    const int g = lane >> 4, i16 = lane & 15, q4 = i16 >> 2, p3 = i16 & 3;
    LAS float* stg = (LAS float*)(lds + FF_STG + w * FF_STGW);
    constexpr int SP = 16 * NTW + 4;
    constexpr int CH = 2 * NTW;
#pragma unroll 1
    for (int mg = 0; mg < M / 64; ++mg) {
        u32x4 gfv[CH];
        if (MODE == 1) {
#pragma unroll
            for (int it = 0; it < CH; ++it) { const int idx = lane + 64 * it, rr = idx / CH, cc = idx % CH; const int tok = tokbase + aux + N1 * (64 * mg + rr);
                gfv[it] = *(const u32x4*)(GF + (size_t)tok * 256 + colbase + 16 * NTW * w + 8 * cc); }
        }
        float2 tw[4][2];
        if (MODE == 0) {
#pragma unroll
            for (int mi = 0; mi < 4; ++mi) { const int k1 = 32 * mg + 8 * mi + 2 * g; tw[mi][0] = TW[aux * k1]; tw[mi][1] = TW[aux * (k1 + 1)]; }
        }
        f32x4 acc[4][NTW];
#pragma unroll
        for (int mi = 0; mi < 4; ++mi)
#pragma unroll
            for (int ni = 0; ni < NTW; ++ni) acc[mi][ni] = (f32x4){0.f, 0.f, 0.f, 0.f};
        constexpr int AMASK = (MODE == 0 ? K / 2 : 64) - 1;
        const LAS unsigned* tabw = (const LAS unsigned*)(lds + FF_TAB) + tabofs;
#pragma unroll 4
        for (int ks = 0; ks < K / 32; ++ks) {
            bf16x8 a[4], b[NTW];
#pragma unroll
            for (int mi = 0; mi < 4; ++mi) { const int mrow = 64 * mg + 16 * mi + i16; const int kk = (MODE == 0) ? (mrow >> 1) : mrow;
                const LAS unsigned* tb = tabw + ((MODE == 0) ? (mrow & 1) * (AMASK + 1) : 0);
                const int i0 = kk * (16 * ks + 4 * g);
                u32x4 wv; wv.x = tb[i0 & AMASK]; wv.y = tb[(i0 + kk) & AMASK]; wv.z = tb[(i0 + 2 * kk) & AMASK]; wv.w = tb[(i0 + 3 * kk) & AMASK];
                a[mi] = __builtin_bit_cast(bf16x8, wv); }
#pragma unroll
            for (int ni = 0; ni < NTW; ++ni) {
                const int n0 = 16 * (NTW * w + ni), img = n0 >> 7, chb = ((n0 & 127) >> 3) + (p3 >> 1);
                const int row0 = 32 * ks + 8 * g + q4, row1 = row0 + 4;
                const LAS unsigned char* base = lds + FF_DATA + img * (K * 256) + 8 * (p3 & 1);
                const s16x4 lo = vtr(base + row0 * 256 + ((chb ^ (((row0 & 3) << 2) | ((row0 >> 2) & 3))) << 4));
                const s16x4 hi4 = vtr(base + row1 * 256 + ((chb ^ (((row1 & 3) << 2) | ((row1 >> 2) & 3))) << 4));
                b[ni] = (bf16x8){lo[0], lo[1], lo[2], lo[3], hi4[0], hi4[1], hi4[2], hi4[3]};
            }
#pragma unroll
            for (int mi = 0; mi < 4; ++mi)
#pragma unroll
                for (int ni = 0; ni < NTW; ++ni) acc[mi][ni] = __builtin_amdgcn_mfma_f32_16x16x32_bf16(a[mi], b[ni], acc[mi][ni], 0, 0, 0);
        }
#pragma unroll
        for (int mi = 0; mi < 4; ++mi)
#pragma unroll
            for (int ni = 0; ni < NTW; ++ni) {
                f32x4 v = acc[mi][ni];
                if (MODE == 0) {
                    const float2 t0 = tw[mi][0], t1 = tw[mi][1];
                    const float r0 = v[0] * t0.x + v[1] * t0.y, i0 = v[1] * t0.x - v[0] * t0.y;
                    const float r1 = v[2] * t1.x + v[3] * t1.y, i1 = v[3] * t1.x - v[2] * t1.y;
                    v = (f32x4){r0, i0, r1, i1};
                }
#pragma unroll
                for (int reg = 0; reg < 4; ++reg) stg[(16 * mi + 4 * g + reg) * SP + 16 * ni + i16] = v[reg];
            }
        LDS_WAIT();
#pragma unroll
        for (int it = 0; it < CH; ++it) {
            const int idx = lane + 64 * it, rr = idx / CH, cc = idx % CH;
            const f32x4 x0 = *(const LAS f32x4*)(stg + rr * SP + 8 * cc), x1 = *(const LAS f32x4*)(stg + rr * SP + 8 * cc + 4);
            const int m = 64 * mg + rr; const int col = colbase + 16 * NTW * w + 8 * cc;
            if (MODE == 0) {
                const int k1 = m >> 1, part = m & 1;
                bf16_t* dst = Out + (size_t)(tokbase + k1 * 64 + aux) * 512 + part * 256 + col;
                *(u32x4*)dst = (u32x4){pk2(x0[0], x0[1]), pk2(x0[2], x0[3]), pk2(x1[0], x1[1]), pk2(x1[2], x1[3])};
            } else {
                const int tok = tokbase + aux + N1 * m;
                const u32x4 gg = gfv[it];
                bf16_t* dst = Out + (size_t)tok * DM + DATT + col;
                *(u32x4*)dst = (u32x4){pk2(x0[0] * bflo(gg.x), x0[1] * bfhi(gg.x)), pk2(x0[2] * bflo(gg.y), x0[3] * bfhi(gg.y)),
                                       pk2(x1[0] * bflo(gg.z), x1[1] * bfhi(gg.z)), pk2(x1[2] * bflo(gg.w), x1[3] * bfhi(gg.w))};
            }
        }
        LDS_WAIT();
    }
}
template <int M, int K, int N>
DI void fft1_compute(LAS unsigned char* lds, int tabofs  , bf16_t* Out, const float2* TW, int tokbase, int s2, int colbase) {
    constexpr int MT = M / 128, NT = N / 16;
    constexpr int AMASK = K / 2 - 1;
    const int tid = fresh_tid(), lane = tid & 63, w = __builtin_amdgcn_readfirstlane(tid >> 6);
    const int g = lane >> 4, i16 = lane & 15, q4 = i16 >> 2, p3 = i16 & 3;
    LAS float* stg = (LAS float*)(lds + FF_STG + w * FF_STGW);
    const LAS unsigned* tabw = (const LAS unsigned*)(lds + FF_TAB) + tabofs;
    f32x4 acc[MT][NT];
#pragma unroll
    for (int mi = 0; mi < MT; ++mi)
#pragma unroll
        for (int ni = 0; ni < NT; ++ni) acc[mi][ni] = (f32x4){0.f, 0.f, 0.f, 0.f};
    float2 tw[MT][2];
#pragma unroll
    for (int mi = 0; mi < MT; ++mi) { const int k1 = 8 * (MT * w + mi) + 2 * g; tw[mi][0] = TW[s2 * k1]; tw[mi][1] = TW[s2 * (k1 + 1)]; }
#pragma unroll 2
    for (int ks = 0; ks < K / 32; ++ks) {
        bf16x8 a[MT];
#pragma unroll
        for (int mi = 0; mi < MT; ++mi) { const int mrow = 16 * (MT * w + mi) + i16; const int kk = mrow >> 1;
            const LAS unsigned* tb = tabw + (mrow & 1) * (AMASK + 1);
            const int i0 = kk * (16 * ks + 4 * g);
            u32x4 wv; wv.x = tb[i0 & AMASK]; wv.y = tb[(i0 + kk) & AMASK]; wv.z = tb[(i0 + 2 * kk) & AMASK]; wv.w = tb[(i0 + 3 * kk) & AMASK];
            a[mi] = __builtin_bit_cast(bf16x8, wv); }
        const int row0 = 32 * ks + 8 * g + q4, row1 = row0 + 4;
        const int x0 = ((row0 & 3) << 2) | ((row0 >> 2) & 3), x1 = ((row1 & 3) << 2) | ((row1 >> 2) & 3);
#pragma unroll
        for (int ni = 0; ni < NT; ++ni) {
            const int n0 = 16 * ni, img = n0 >> 7, chb = ((n0 & 127) >> 3) + (p3 >> 1);
            const LAS unsigned char* base = lds + FF_DATA + img * (K * 256) + 8 * (p3 & 1);
            const s16x4 lo = vtr(base + row0 * 256 + ((chb ^ x0) << 4));
            const s16x4 hi4 = vtr(base + row1 * 256 + ((chb ^ x1) << 4));
            const bf16x8 b = (bf16x8){lo[0], lo[1], lo[2], lo[3], hi4[0], hi4[1], hi4[2], hi4[3]};
#pragma unroll
            for (int mi = 0; mi < MT; ++mi) acc[mi][ni] = __builtin_amdgcn_mfma_f32_16x16x32_bf16(a[mi], b, acc[mi][ni], 0, 0, 0);
        }
    }
    constexpr int SP = 132;
#pragma unroll
    for (int mi = 0; mi < MT; ++mi)
#pragma unroll
        for (int grp = 0; grp < NT / 8; ++grp) {
#pragma unroll
            for (int n8 = 0; n8 < 8; ++n8) {
                f32x4 v = acc[mi][8 * grp + n8];
                const float2 t0 = tw[mi][0], t1 = tw[mi][1];
                const float r0 = v[0] * t0.x + v[1] * t0.y, i0_ = v[1] * t0.x - v[0] * t0.y;
                const float r1 = v[2] * t1.x + v[3] * t1.y, i1_ = v[3] * t1.x - v[2] * t1.y;
                stg[(4 * g + 0) * SP + 16 * n8 + i16] = r0; stg[(4 * g + 1) * SP + 16 * n8 + i16] = i0_;
                stg[(4 * g + 2) * SP + 16 * n8 + i16] = r1; stg[(4 * g + 3) * SP + 16 * n8 + i16] = i1_;
            }
            LDS_WAIT();
#pragma unroll
            for (int it = 0; it < 4; ++it) {
                const int rr = 4 * it + (lane >> 4), cc = lane & 15;
                const f32x4 y0 = *(const LAS f32x4*)(stg + rr * SP + 8 * cc), y1 = *(const LAS f32x4*)(stg + rr * SP + 8 * cc + 4);
                const int m = 16 * (MT * w + mi) + rr, k1 = m >> 1, part = m & 1;
                bf16_t* dst = Out + (size_t)(tokbase + k1 * 64 + s2) * 512 + part * 256 + colbase + 128 * grp + 8 * cc;
                *(u32x4*)dst = (u32x4){pk2(y0[0], y0[1]), pk2(y0[2], y0[3]), pk2(y1[0], y1[1]), pk2(y1[2], y1[3])};
            }
            LDS_WAIT();
        }
}
DI FSrc fft1_src(const bf16_t* Z, int it) {
    FSrc s; s.row_stride = 64 * 512; s.part_off = 256;
    if (it < 512) { const int half = it & 1, s2 = (it >> 1) & 63, b = it >> 7; s.p = Z + (size_t)(b * 8192 + s2) * 512 + half * 128; s.cpr_shift = 4; }
    else { const int j = it - 512, s2 = j & 63, b = j >> 6; s.p = Z + (size_t)(NPT + b * 4096 + s2) * 512; s.cpr_shift = 5; }
    return s;
}
DI void fft_stage1(const Params& P, LAS unsigned char* lds) {
    const int G = gridDim.x, bx = blockIdx.x; unsigned char* ws = P.ws; const int tid = fresh_tid();
    bf16_t* Y = (bf16_t*)((unsigned char*)P.out + DO_Z); const bf16_t* Z = Y;
    { LAS unsigned* tabw = (LAS unsigned*)(lds + FF_TAB);
      if (tid < 256) { const int po = tid >> 7, idx = tid & 127; tabw[tid] = *(const unsigned*)((const bf16_t*)(ws + WS_F1P) + (2 + po) * 256 + 2 * idx); }
      else if (tid < 384) { const int q = tid - 256, po = q >> 6, idx = q & 63; tabw[tid] = *(const unsigned*)((const bf16_t*)(ws + WS_F1S) + (2 + po) * 128 + 2 * idx); } }
    u32x4 t[8];
    int it = bx;
    if (it < 1024) fft_fetch(fft1_src(Z, it), tid, t);
    for (; it < 1024; it += G) {
        __syncthreads();
        if (it < 512) fft_commit<256>(lds, 4, tid, t); else fft_commit<128>(lds, 5, tid, t);
        __syncthreads();
        if (it + G < 1024) fft_fetch(fft1_src(Z, it + G), tid, t);
        if (it < 512) { const int half = it & 1, s2 = (it >> 1) & 63, b = it >> 7;
            fft1_compute<256, 256, 128>(lds, 0, Y, (const float2*)(ws + WS_TWP), b * 8192, s2, half * 128);
        } else { const int j = it - 512, s2 = j & 63, b = j >> 6;
            fft1_compute<128, 128, 256>(lds, 256, Y, (const float2*)(ws + WS_TWS), NPT + b * 4096, s2, 0); }
    }
    __syncthreads();
}
DI FSrc fft2_src(const bf16_t* Y, int it) {
    FSrc s; s.row_stride = 512; s.part_off = 256; s.cpr_shift = 5;
    if (it < 512) { const int b = it >> 7, k1 = it & 127; s.p = Y + (size_t)(b * 8192 + k1 * 64) * 512; }
    else { const int j = it - 512, b = j >> 6, k1 = j & 63; s.p = Y + (size_t)(NPT + b * 4096 + k1 * 64) * 512; }
    return s;
}
DI void fft_stage2(const Params& P, LAS unsigned char* lds) {
    const int G = gridDim.x, bx = blockIdx.x; unsigned char* ws = P.ws; const int tid = fresh_tid();
    const bf16_t* Y = (const bf16_t*)((unsigned char*)P.out + DO_Z); bf16_t* MIX = (bf16_t*)(ws + WS_H); const bf16_t* GF = (const bf16_t*)(ws + WS_GF);
    if (tid < 64) ((LAS unsigned*)(lds + FF_TAB))[tid] = *(const unsigned*)((const bf16_t*)(ws + WS_F2) + 128 + 2 * tid);
    u32x4 t[8];
    int it = bx;
    if (it < 1024) fft_fetch(fft2_src(Y, it), tid, t);
    for (; it < 1024; it += G) {
        __syncthreads();
        fft_commit<128>(lds, 5, tid, t);
        __syncthreads();
        if (it + G < 1024) fft_fetch(fft2_src(Y, it + G), tid, t);
        int tokb, k1, N1;
        if (it < 512) { const int b = it >> 7; k1 = it & 127; tokb = b * 8192; N1 = 128; }
        else { const int j = it - 512, b = j >> 6; k1 = j & 63; tokb = NPT + b * 4096; N1 = 64; }
        fft_compute<64, 128, 256, 1>(lds, 0, MIX, nullptr, GF, tokb, k1, N1, 0);
    }
    __syncthreads();
}

#define XB_TMO      128
#define XB_XCNT(j)  (256  + 64 * (j))
#define XB_XSUB(j)  (1280 + 64 * (j))
#define XB_XGEN(j)  (2304 + 64 * (j))
#define XB_TOP      3328
#define XB_TOPGEN   3392
#define XCD_BAR_WORDS 3456
#define XB_SPIN_CAP (1u << 18)
DI unsigned xb_ld(unsigned* p)              { return __hip_atomic_load(p, __ATOMIC_RELAXED, __HIP_MEMORY_SCOPE_AGENT); }
DI unsigned xb_add(unsigned* p, unsigned v) { return __hip_atomic_fetch_add(p, v, __ATOMIC_RELAXED, __HIP_MEMORY_SCOPE_AGENT); }
DI unsigned xb_xcc_id() { return (unsigned)__builtin_amdgcn_s_getreg((3 << 11) | 20) & 0xFu; }
#define XB_SPIN(cond, bar) do { unsigned _sp = 0; while (cond) { __builtin_amdgcn_s_sleep(1); \
    if ((++_sp & 255u) == 0u) { if (xb_ld(&(bar)[XB_TMO])) break; if (_sp > XB_SPIN_CAP) { atomicAdd(&(bar)[XB_TMO], 1u); break; } } } } while (0)
struct XcdBarrier { unsigned* bar; unsigned x; volatile LAS unsigned* st; };
DI XcdBarrier xcd_barrier_post(unsigned* bar, volatile LAS unsigned* st) {
    XcdBarrier b; b.bar = bar; b.x = xb_xcc_id(); b.st = st;
    if (threadIdx.x == 0) (void)xb_add(&bar[XB_XCNT(b.x)], 1u);
    return b;
}
DI void xcd_barrier_complete(unsigned* bar, unsigned x, unsigned& nloc, unsigned& nx) {
    const unsigned G = gridDim.x * gridDim.y * gridDim.z;
    unsigned sum, cnt, mine, sp = 0u;
    for (;;) {
        sum = 0u; cnt = 0u; mine = 0u;
#pragma unroll
        for (unsigned j = 0; j < 16; ++j) { const unsigned c = xb_ld(&bar[XB_XCNT(j)]); sum += c; cnt += (c > 0u) ? 1u : 0u; mine = (j == x) ? c : mine; }
        if (sum == G) break;
        __builtin_amdgcn_s_sleep(1);
        if ((++sp & 255u) == 0u) { if (xb_ld(&bar[XB_TMO])) break; if (sp > XB_SPIN_CAP) { atomicAdd(&bar[XB_TMO], 1u); break; } }
    }
    nloc = mine > 0u ? mine : 1u; nx = cnt > 0u ? cnt : 1u;
}
DI void xcd_barrier(const XcdBarrier& b) {
    asm volatile("s_waitcnt vmcnt(0)" ::: "memory");
    __syncthreads();
    if (threadIdx.x == 0) {
        unsigned* bar = b.bar;
        __builtin_amdgcn_s_waitcnt(0);
        unsigned nloc = b.st[0], nx = b.st[1];
        if (nloc == 0u) { xcd_barrier_complete(bar, b.x, nloc, nx); b.st[0] = nloc; b.st[1] = nx; }
        const unsigned old = xb_add(&bar[XB_XSUB(b.x)], 1u);
        const unsigned gen = old / nloc;
        if (old + 1u == (gen + 1u) * nloc) {
            __builtin_amdgcn_fence(__ATOMIC_RELEASE, "agent");
            asm volatile("s_waitcnt vmcnt(0)" ::: "memory");
            const unsigned og = xb_add(&bar[XB_TOP], 1u);
            const unsigned tg = og / nx;
            if (og + 1u == (tg + 1u) * nx) xb_add(&bar[XB_TOPGEN], 1u);
            else XB_SPIN(xb_ld(&bar[XB_TOPGEN]) == tg, bar);
            __builtin_amdgcn_fence(__ATOMIC_ACQUIRE, "agent");
            xb_add(&bar[XB_XGEN(b.x)], 1u);
            asm volatile("s_waitcnt vmcnt(0)" ::: "memory");
        } else {
            XB_SPIN(xb_ld(&bar[XB_XGEN(b.x)]) == gen, bar);
            __builtin_amdgcn_fence(__ATOMIC_ACQUIRE, "agent");
            asm volatile("s_waitcnt vmcnt(0)" ::: "memory");
        }
    }
    __syncthreads();
}

constexpr int LDS_BYTES = 163840;
constexpr int EPI_STG = 131072;
constexpr int NPHASE = 8;
template <int LO, int HI, bool COOP>
__global__ void __launch_bounds__(512, 2) mk_fwd(Params P) {
    extern __shared__ __attribute__((aligned(16))) unsigned char lds_raw[];
    LAS unsigned char* lds = (LAS unsigned char*)lds_raw;
    const int G = gridDim.x;
#define IN(k) (LO <= (k) && (k) < HI)
#define SEAM(k) do { if constexpr (COOP && IN(k) && IN((k) + 1)) { xcd_barrier(xbar); } } while (0)
    unsigned char* ws = P.ws; unsigned char* dob = (unsigned char*)P.out;
    XcdBarrier xbar; xbar.bar = (unsigned*)(ws + WS_CTL); xbar.x = 0; xbar.st = (volatile LAS unsigned*)(lds + LDS_BYTES - 256);
    if constexpr (COOP) {
        if (threadIdx.x < 2) xbar.st[threadIdx.x] = 0u;
        __syncthreads();
        xbar = xcd_barrier_post(xbar.bar, xbar.st);
        if (P.ws == nullptr) cg::this_grid().sync();
    }
    if constexpr (IN(0)) { p0_prologue(P, lds); __syncthreads(); SEAM(0); }
    if constexpr (IN(1)) {
        pg8::Gemm g{(const bf16_t*)(ws + WS_H), (const bf16_t*)(ws + WS_WIN), NTOK, NPROJ, DM};
        pg8::StaticOrder S; S.init(NTOK, NPROJ, G, (int)blockIdx.x);
        EpiInProj E{(bf16_t*)(dob + DO_Q), (bf16_t*)(dob + DO_K), (bf16_t*)(ws + WS_V), (bf16_t*)(ws + WS_GA), (bf16_t*)(dob + DO_Z), (bf16_t*)(ws + WS_GF), P.qg, P.kg};
        pg8::gemm_phase<EpiInProj, pg8::StaticOrder, true, true>(lds, g, S, E);
        SEAM(1);
    }
    if constexpr (IN(2)) { fft_stage1(P, lds); }
    if constexpr (IN(3)) { attn_chunks(P, lds, 0, (G == 256) ? 3 : (1536 + 2 * G - 1) / (2 * G)); SEAM(3); }
    if constexpr (IN(4)) { fft_stage2(P, lds); }
    if constexpr (IN(5)) { attn_chunks(P, lds, (G == 256) ? 3 : (1536 + 2 * G - 1) / (2 * G), (G == 256) ? 6 : (1536 + G - 1) / G); }
    if constexpr (IN(6)) { SEAM(6); }
    if constexpr (IN(7)) {
        pg8::Gemm g{(const bf16_t*)(ws + WS_H), (const bf16_t*)(ws + WS_WOUT), NTOK, DM, DM};
        pg8::StaticOrder S; S.init(NTOK, DM, G, (int)blockIdx.x, 1);
        EpiOut E{P.xp, P.xs, P.out, lds + EPI_STG};
        pg8::gemm_phase<EpiOut, pg8::StaticOrder, true, true>(lds, g, S, E);
    }
#undef IN
#undef SEAM
}

#ifndef MK_PROBE
#define MK_PROBE -1
#endif
extern "C" void kernel_launch(void* const* d_in, const int* in_sizes, int n_in, void* d_out, int out_size, void* d_ws, size_t ws_size, hipStream_t stream) {
    static int grid = 0;
    auto kfn = mk_fwd<0, NPHASE, true>;
    if (grid == 0) {
        if (n_in != 9 || in_sizes[0] != NPT * DM || in_sizes[1] != NPT * DM || out_size != NTOK * DM || ws_size < WS_END) {
            fprintf(stderr, "kernel_launch: unexpected shapes (n_in %d, out %d, ws %zu); nothing launched\n", n_in, out_size, ws_size); grid = -1; return; }
        int dev = 0, cus = 0, per_cu = 0;
        if (hipGetDevice(&dev) != hipSuccess || hipDeviceGetAttribute(&cus, hipDeviceAttributeMultiprocessorCount, dev) != hipSuccess) { grid = -1; return; }
        if (hipFuncSetAttribute((const void*)kfn, hipFuncAttributeMaxDynamicSharedMemorySize, LDS_BYTES) != hipSuccess) { fprintf(stderr, "kernel_launch: hipFuncSetAttribute failed\n"); grid = -1; return; }
        if (hipOccupancyMaxActiveBlocksPerMultiprocessor(&per_cu, (const void*)kfn, 512, LDS_BYTES) != hipSuccess || per_cu < 1) { fprintf(stderr, "kernel_launch: occupancy query failed (%d)\n", per_cu); grid = -1; return; }
        grid = cus * 1;
    }
    if (grid < 0) return;
    Params p{};
    p.xp = (const float*)d_in[0]; p.xs = (const float*)d_in[1]; p.norm_g = (const float*)d_in[2]; p.w_in = (const float*)d_in[3];
    p.qg = (const float*)d_in[4]; p.kg = (const float*)d_in[5]; p.rel_bias = (const float*)d_in[6]; p.w_four = (const float*)d_in[7]; p.w_out = (const float*)d_in[8];
    p.out = (float*)d_out; p.ws = (unsigned char*)d_ws;
#if MK_PROBE >= 0
#define LP(LO, HI) do { static bool at_ = false; auto k_ = mk_fwd<LO, HI, false>; if (!at_) { (void)hipFuncSetAttribute((const void*)k_, hipFuncAttributeMaxDynamicSharedMemorySize, LDS_BYTES); at_ = true; } \
        hipLaunchKernelGGL(k_, dim3(grid), dim3(512), LDS_BYTES, stream, p); } while (0)
    LP(0, 1); if (MK_PROBE == 0) LP(0, 1);
    LP(1, 2); if (MK_PROBE == 1) LP(1, 2);
    if (MK_PROBE == 5) LP(5, 6);
    if (MK_PROBE == 6) LP(6, 7);
    LP(2, 3);
    LP(3, 4); if (MK_PROBE == 3) LP(3, 4);
    LP(4, 5); if (MK_PROBE == 4) LP(4, 5);
    LP(5, 6); LP(6, 7);
    LP(7, 8); if (MK_PROBE == 7) LP(7, 8);
#else
    if (hipMemsetAsync((char*)d_ws + WS_CTL, 0, XCD_BAR_WORDS * 4, stream) != hipSuccess) { fprintf(stderr, "kernel_launch: hipMemsetAsync failed\n"); return; }
    void* args[] = {&p};
    const hipError_t e = hipLaunchCooperativeKernel((const void*)kfn, dim3(grid), dim3(512), args, LDS_BYTES, stream);
    if (e != hipSuccess) fprintf(stderr, "kernel_launch: cooperative launch failed: %s (grid %d)\n", hipGetErrorString(e), grid);
#endif
}
```
